# Optimizing an MI355X kernel written in HIP

```python
import math
import jax, jax.numpy as jnp
from jax import lax
import numpy as np

D_MODEL = 2048
BATCH = 4
SEQ = 2048
DEPTH = 1
DEC_BATCH = 32
DEC_SEQ = 4
PAST_LEN = 8192
PAGE_SIZE = 128

SSM_WIDTH = D_MODEL // 2
SSM_GROUP = 16
SSM_GROUPS = SSM_WIDTH // SSM_GROUP
SSM_STATE = 64
DT_MIN = 0.001
DT_MAX = 0.1
N_HEADS = 8
HEAD_DIM = 128
N_KV_HEADS = 2
N_REP = N_HEADS // N_KV_HEADS
ATTN_WIDTH = N_HEADS * HEAD_DIM
KV_WIDTH = N_KV_HEADS * HEAD_DIM
ROT_DIM = HEAD_DIM // 4
ROPE_THETA = 500000.0
IDX_HEADS = 16
IDX_DIM = 64
IDX_ROT_DIM = IDX_DIM // 4
TOPK_MAX = 256
Q_BLOCK = 128
D_FF = 5632
FFN_RES = 0.5
EPS = 1e-6

IN_SIZES = [SSM_WIDTH, ATTN_WIDTH, KV_WIDTH, KV_WIDTH, IDX_HEADS * IDX_DIM, IDX_DIM, IDX_HEADS, D_MODEL, D_MODEL]
IN_WIDTH = sum(IN_SIZES)
IN_SPLITS = [sum(IN_SIZES[: i + 1]) for i in range(len(IN_SIZES) - 1)]

kernel_name = "hybrid_s5_dsa_macaron_step"


def _rms_norm(x, g):
    xf = x.astype(jnp.float32)
    y = xf * lax.rsqrt(jnp.mean(xf * xf, axis=-1, keepdims=True) + EPS)
    return (y * g.astype(jnp.float32)).astype(x.dtype)


def _swiglu(x, w_gate, w_up, w_down):
    return (jax.nn.silu(x @ w_gate) * (x @ w_up)) @ w_down


def _rope_partial(x, pos, rot_dim):
    half = rot_dim // 2
    freqs = ROPE_THETA ** (-jnp.arange(half, dtype=jnp.float32) * 2.0 / rot_dim)
    ang = pos.astype(jnp.float32)[:, None] * freqs[None, :]
    cos = jnp.cos(ang)[None, :, None, :]
    sin = jnp.sin(ang)[None, :, None, :]
    xr = x[..., :rot_dim].astype(jnp.float32)
    x1, x2 = xr[..., :half], xr[..., half:]
    rot = jnp.concatenate([x1 * cos - x2 * sin, x2 * cos + x1 * sin], axis=-1).astype(x.dtype)
    return jnp.concatenate([rot, x[..., rot_dim:]], axis=-1)


def _take_rows(t, idx):
    return jax.vmap(lambda tb, ib: tb[ib])(t, idx)


def _ssm_discretize(lam_re, lam_im, b_re, b_im, log_dt):
    f32 = jnp.float32
    lam = lax.complex(lam_re.astype(f32), lam_im.astype(f32))
    dt = jnp.exp(log_dt.astype(f32))[:, None]
    lam_bar = jnp.exp(lam * dt)
    b = lax.complex(b_re.astype(f32), b_im.astype(f32))
    b_bar = ((lam_bar - 1.0) / lam)[..., None] * b
    return lam_bar, b_bar


def _ssm_scan(u, h0, lam_bar, b_bar, c, d):
    uf = u.astype(jnp.float32)
    bu = jnp.einsum('gph,bsgh->bsgp', b_bar, uf.astype(jnp.complex64))
    bu = bu.at[:, 0].add(lam_bar[None] * h0)
    a = jnp.broadcast_to(lam_bar, bu.shape)

    def combine(e1, e2):
        a1, b1 = e1
        a2, b2 = e2
        return a1 * a2, a2 * b1 + b2

    _, h = lax.associative_scan(combine, (a, bu), axis=1)
    y = jnp.real(jnp.einsum('ghp,bsgp->bsgh', c, h)) + d.astype(jnp.float32) * uf
    return y.astype(u.dtype), h[:, -1]


def _indexer_select(qi, wi, ki, q_pos, top_k):
    s = jnp.einsum('bqhd,bld->bqhl', qi, ki).astype(jnp.float32) * (IDX_DIM ** -0.5)
    s = jnp.einsum('bqhl,bqh->bql', jax.nn.relu(s), wi.astype(jnp.float32))
    k_pos = jnp.arange(ki.shape[1])
    allowed = k_pos[None, None, :] <= q_pos[None, :, None]
    s = jnp.where(allowed, s, -jnp.inf)
    _, sel = lax.top_k(s, top_k)
    valid = sel <= q_pos[None, :, None]
    return sel, valid


def _sparse_attend(q, k_sel, v_sel, valid):
    b_, q_ = q.shape[:2]
    qg = q.reshape(b_, q_, N_KV_HEADS, N_REP, HEAD_DIM)
    logits = jnp.einsum('bqgrd,bqkgd->bqgrk', qg, k_sel).astype(jnp.float32) * (HEAD_DIM ** -0.5)
    logits = jnp.where(valid[:, :, None, None, :], logits, -jnp.inf)
    prob = jax.nn.softmax(logits, axis=-1).astype(v_sel.dtype)
    out = jnp.einsum('bqgrk,bqkgd->bqgrd', prob, v_sel)
    return out.reshape(b_, q_, ATTN_WIDTH)


def _prompt_attention(q, k, v, qi, wi, ki):
    b_, s_ = q.shape[:2]
    top_k = min(TOPK_MAX, s_ // 4)
    nb = s_ // Q_BLOCK

    def to_blocks(t):
        return jnp.moveaxis(t.reshape(b_, nb, Q_BLOCK, *t.shape[2:]), 1, 0)

    pos_blocks = jnp.arange(s_).reshape(nb, Q_BLOCK)

    def one_block(args):
        qb, qib, wib, pb = args
        sel, valid = _indexer_select(qib, wib, ki, pb, top_k)
        return _sparse_attend(qb, _take_rows(k, sel), _take_rows(v, sel), valid)

    out = lax.map(one_block, (to_blocks(q), to_blocks(qi), to_blocks(wi), pos_blocks))
    return jnp.moveaxis(out, 0, 1).reshape(b_, s_, ATTN_WIDTH)


def _sample_attention(q, k_new, v_new, qi, wi, ki_new, cache_k, cache_v, cache_idx_k, page_table):
    db, t_ = q.shape[:2]
    n_pages = page_table.shape[1]
    past = n_pages * PAGE_SIZE
    top_k = min(TOPK_MAX, (past + t_) // 4)
    ki_past = cache_idx_k[page_table].reshape(db, past, IDX_DIM)
    ki_all = jnp.concatenate([ki_past, ki_new.astype(ki_past.dtype)], axis=1)
    q_pos = past + jnp.arange(t_)
    sel, valid = _indexer_select(qi, wi, ki_all, q_pos, top_k)
    in_past = (sel < past)[..., None, None]
    page_ix = jnp.minimum(sel // PAGE_SIZE, n_pages - 1)
    phys = _take_rows(page_table, page_ix)
    off = sel % PAGE_SIZE
    new_ix = jnp.clip(sel - past, 0, t_ - 1)
    k_sel = jnp.where(in_past, cache_k[phys, off], _take_rows(k_new, new_ix).astype(cache_k.dtype))
    v_sel = jnp.where(in_past, cache_v[phys, off], _take_rows(v_new, new_ix).astype(cache_v.dtype))
    return _sparse_attend(q, k_sel.astype(q.dtype), v_sel.astype(q.dtype), valid)


def _token_mix(x, pos, h0, attend_fn, p, lam_bar, b_bar, c_ssm):
    b_, s_ = x.shape[:2]
    h = _rms_norm(x, p['mix_norm'])
    z = h @ p['w_in']
    u, q, k, v, qi, ki, wi, ga, gb = jnp.split(z, IN_SPLITS, axis=-1)
    u = u.reshape(b_, s_, SSM_GROUPS, SSM_GROUP)
    y_ssm, h_last = _ssm_scan(u, h0, lam_bar, b_bar, c_ssm, p['ssm_d'])
    za = jax.nn.gelu(y_ssm.reshape(b_, s_, SSM_WIDTH))
    a_out = za * jax.nn.sigmoid(za @ p['glu_w'] + p['glu_b'])
    q = _rope_partial(_rms_norm(q.reshape(b_, s_, N_HEADS, HEAD_DIM), p['q_norm']), pos, ROT_DIM)
    k = _rope_partial(_rms_norm(k.reshape(b_, s_, N_KV_HEADS, HEAD_DIM), p['k_norm']), pos, ROT_DIM)
    v = v.reshape(b_, s_, N_KV_HEADS, HEAD_DIM)
    qi = _rope_partial(qi.reshape(b_, s_, IDX_HEADS, IDX_DIM), pos, IDX_ROT_DIM)
    ki = _rope_partial(ki[:, :, None, :], pos, IDX_ROT_DIM)[:, :, 0, :]
    wi = wi * (IDX_HEADS ** -0.5)
    b_out = attend_fn(q, k, v, qi, wi, ki)
    merged = jax.nn.sigmoid(ga) * (a_out @ p['w_branch_a']) + jax.nn.sigmoid(gb) * (b_out @ p['w_branch_b'])
    return x + merged @ p['w_out'], (k, v, ki, h_last)


def _layer(x_p, x_s, ck, cv, cik, s_re, s_im, page_table, p):
    f32 = jnp.float32
    past = page_table.shape[1] * PAGE_SIZE
    s_len, t_len = x_p.shape[1], x_s.shape[1]
    x_p = x_p + FFN_RES * _swiglu(_rms_norm(x_p, p['ffn1_norm']), p['ffn1_w_gate'], p['ffn1_w_up'], p['ffn1_w_down'])
    x_s = x_s + FFN_RES * _swiglu(_rms_norm(x_s, p['ffn1_norm']), p['ffn1_w_gate'], p['ffn1_w_up'], p['ffn1_w_down'])
    lam_bar, b_bar = _ssm_discretize(p['ssm_lambda_re'], p['ssm_lambda_im'], p['ssm_b_re'], p['ssm_b_im'], p['ssm_log_dt'])
    c_ssm = lax.complex(p['ssm_c_re'].astype(f32), p['ssm_c_im'].astype(f32))
    h0_p = jnp.zeros((x_p.shape[0], SSM_GROUPS, SSM_STATE), jnp.complex64)
    h0_s = lax.complex(s_re.astype(f32), s_im.astype(f32))

    def attn_s(q, k, v, qi, wi, ki):
        return _sample_attention(q, k, v, qi, wi, ki, ck, cv, cik, page_table)

    x_p, (kp, vp, kip, hp) = _token_mix(x_p, jnp.arange(s_len), h0_p, _prompt_attention, p, lam_bar, b_bar, c_ssm)
    x_s, (ks, vs, kis, hs) = _token_mix(x_s, past + jnp.arange(t_len), h0_s, attn_s, p, lam_bar, b_bar, c_ssm)
    x_p = x_p + FFN_RES * _swiglu(_rms_norm(x_p, p['ffn2_norm']), p['ffn2_w_gate'], p['ffn2_w_up'], p['ffn2_w_down'])
    x_s = x_s + FFN_RES * _swiglu(_rms_norm(x_s, p['ffn2_norm']), p['ffn2_w_gate'], p['ffn2_w_up'], p['ffn2_w_down'])
    rows = (kp, vp, kip, jnp.real(hp), jnp.imag(hp), ks, vs, kis, jnp.real(hs), jnp.imag(hs))
    return x_p, x_s, rows


def setup_inputs(seed: int = 0) -> dict:
    key = jax.random.key(seed)
    k = jax.random.split(key, 33)
    f32 = jnp.float32
    n_pages = PAST_LEN // PAGE_SIZE
    n_phys = (DEC_BATCH * n_pages * 5) // 4

    def nrm(kk, shape, scale):
        return jax.random.normal(kk, shape, f32) * scale

    def gain(kk, n):
        return 1.0 + 0.02 * jax.random.normal(kk, (DEPTH, n), f32)

    page_table = jax.random.permutation(k[7], n_phys)[: DEC_BATCH * n_pages].reshape(DEC_BATCH, n_pages).astype(jnp.int32)
    lam_re = -0.5 + 0.01 * jax.random.normal(k[16], (DEPTH, SSM_GROUPS, SSM_STATE), f32)
    lam_im = math.pi * jnp.arange(SSM_STATE, dtype=f32)[None, None, :] + 0.01 * jax.random.normal(k[17], (DEPTH, SSM_GROUPS, SSM_STATE), f32)
    log_dt = jax.random.uniform(k[23], (DEPTH, SSM_GROUPS), f32, math.log(DT_MIN), math.log(DT_MAX))
    return {
        'x_prompt': nrm(k[0], (BATCH, SEQ, D_MODEL), 1.0),
        'x_sample': nrm(k[1], (DEC_BATCH, DEC_SEQ, D_MODEL), 1.0),
        'cache_k': nrm(k[2], (DEPTH, n_phys, PAGE_SIZE, N_KV_HEADS, HEAD_DIM), 1.0),
        'cache_v': nrm(k[3], (DEPTH, n_phys, PAGE_SIZE, N_KV_HEADS, HEAD_DIM), 1.0),
        'cache_idx_k': nrm(k[4], (DEPTH, n_phys, PAGE_SIZE, IDX_DIM), 1.0),
        'state_ssm_re': nrm(k[5], (DEPTH, DEC_BATCH, SSM_GROUPS, SSM_STATE), 0.5),
        'state_ssm_im': nrm(k[6], (DEPTH, DEC_BATCH, SSM_GROUPS, SSM_STATE), 0.5),
        'page_table': page_table,
        'ffn1_norm': gain(k[8], D_MODEL),
        'ffn1_w_gate': nrm(k[9], (DEPTH, D_MODEL, D_FF), D_MODEL ** -0.5),
        'ffn1_w_up': nrm(k[10], (DEPTH, D_MODEL, D_FF), D_MODEL ** -0.5),
        'ffn1_w_down': nrm(k[11], (DEPTH, D_FF, D_MODEL), D_FF ** -0.5),
        'mix_norm': gain(k[12], D_MODEL),
        'w_in': nrm(k[13], (DEPTH, D_MODEL, IN_WIDTH), D_MODEL ** -0.5),
        'q_norm': gain(k[14], HEAD_DIM),
        'k_norm': gain(k[15], HEAD_DIM),
        'ssm_lambda_re': lam_re,
        'ssm_lambda_im': lam_im,
        'ssm_b_re': nrm(k[18], (DEPTH, SSM_GROUPS, SSM_STATE, SSM_GROUP), (2 * SSM_GROUP) ** -0.5),
        'ssm_b_im': nrm(k[19], (DEPTH, SSM_GROUPS, SSM_STATE, SSM_GROUP), (2 * SSM_GROUP) ** -0.5),
        'ssm_c_re': nrm(k[20], (DEPTH, SSM_GROUPS, SSM_GROUP, SSM_STATE), SSM_STATE ** -0.5),
        'ssm_c_im': nrm(k[21], (DEPTH, SSM_GROUPS, SSM_GROUP, SSM_STATE), SSM_STATE ** -0.5),
        'ssm_d': nrm(k[22], (DEPTH, SSM_GROUPS, SSM_GROUP), 0.5),
        'ssm_log_dt': log_dt,
        'glu_w': nrm(k[24], (DEPTH, SSM_WIDTH, SSM_WIDTH), SSM_WIDTH ** -0.5),
        'glu_b': nrm(k[25], (DEPTH, SSM_WIDTH), 0.01),
        'w_branch_a': nrm(k[26], (DEPTH, SSM_WIDTH, D_MODEL), SSM_WIDTH ** -0.5),
        'w_branch_b': nrm(k[27], (DEPTH, ATTN_WIDTH, D_MODEL), ATTN_WIDTH ** -0.5),
        'w_out': nrm(k[28], (DEPTH, D_MODEL, D_MODEL), D_MODEL ** -0.5),
        'ffn2_norm': gain(k[29], D_MODEL),
        'ffn2_w_gate': nrm(k[30], (DEPTH, D_MODEL, D_FF), D_MODEL ** -0.5),
        'ffn2_w_up': nrm(k[31], (DEPTH, D_MODEL, D_FF), D_MODEL ** -0.5),
        'ffn2_w_down': nrm(k[32], (DEPTH, D_FF, D_MODEL), D_FF ** -0.5),
    }


def reference(x_prompt, x_sample, cache_k, cache_v, cache_idx_k, state_ssm_re, state_ssm_im, page_table,
              ffn1_norm, ffn1_w_gate, ffn1_w_up, ffn1_w_down, mix_norm, w_in, q_norm, k_norm,
              ssm_lambda_re, ssm_lambda_im, ssm_b_re, ssm_b_im, ssm_c_re, ssm_c_im, ssm_d, ssm_log_dt,
              glu_w, glu_b, w_branch_a, w_branch_b, w_out, ffn2_norm, ffn2_w_gate, ffn2_w_up, ffn2_w_down):
    y_p, y_s = x_prompt, x_sample
    new = [[] for _ in range(10)]
    for l in range(DEPTH):
        p = dict(
            ffn1_norm=ffn1_norm[l], ffn1_w_gate=ffn1_w_gate[l], ffn1_w_up=ffn1_w_up[l], ffn1_w_down=ffn1_w_down[l],
            mix_norm=mix_norm[l], w_in=w_in[l], q_norm=q_norm[l], k_norm=k_norm[l],
            ssm_lambda_re=ssm_lambda_re[l], ssm_lambda_im=ssm_lambda_im[l],
            ssm_b_re=ssm_b_re[l], ssm_b_im=ssm_b_im[l], ssm_c_re=ssm_c_re[l], ssm_c_im=ssm_c_im[l],
            ssm_d=ssm_d[l], ssm_log_dt=ssm_log_dt[l], glu_w=glu_w[l], glu_b=glu_b[l],
            w_branch_a=w_branch_a[l], w_branch_b=w_branch_b[l], w_out=w_out[l],
            ffn2_norm=ffn2_norm[l], ffn2_w_gate=ffn2_w_gate[l], ffn2_w_up=ffn2_w_up[l], ffn2_w_down=ffn2_w_down[l],
        )
        y_p, y_s, rows = _layer(y_p, y_s, cache_k[l], cache_v[l], cache_idx_k[l],
                                state_ssm_re[l], state_ssm_im[l], page_table, p)
        for lst, r in zip(new, rows):
            lst.append(r)
    k_p, v_p, ik_p, re_p, im_p, k_s, v_s, ik_s, re_s, im_s = [jnp.stack(lst) for lst in new]
    return (y_p, y_s, k_p, v_p, ik_p, re_p, im_p, k_s, v_s, ik_s, re_s, im_s)
```

```cpp
#include <hip/hip_runtime.h>
#include <cstdio>
#include <cstdint>
namespace pg8 {
#define PG8_LAS __attribute__((address_space(3)))
typedef unsigned short bf16_t;
typedef short bf16x8 __attribute__((ext_vector_type(8)));
typedef float f32x4 __attribute__((ext_vector_type(4)));
typedef unsigned u32x4 __attribute__((ext_vector_type(4)));
constexpr int BM = 256, BK = 64, HALF = 128, HTB = HALF * BK * 2  , STAGE_BYTES = 8 * HTB, NXCD = 8, WGM = 8;

__host__ __device__ __forceinline__ int lds_byte(int r, int c) { const int st = (r >> 4) * 2 + (c >> 5), rr = r & 15, cc = c & 31, ob = rr * 64 + cc * 2; return st * 1024 + (ob ^ (((ob >> 9) & 1) << 5)); }
__host__ __device__ __forceinline__ void stage_rc(int b, int& R, int& C) { const int st = b / 1024, sb = b % 1024, swz = sb ^ (((sb >> 9) & 1) << 5); R = (st >> 1) * 16 + swz / 64; C = (st & 1) * 32 + (swz % 64) / 2; }
__host__ __device__ __forceinline__ int perm32(int rho) { const int n = rho >> 4, i = rho & 15; return 8 * (i >> 2) + 4 * n + (i & 3); }

struct Unit { int pm, pn, tag, nt, kq, pad_; const char* a; const char* b; };
struct Gemm { int lda, ldb; };

struct StaticOrder {
    int nM, nN, nwg, G, c;
    __host__ __device__ void init(int M, int N, int G_, int c_) { nM = M / BM; nN = N / BM; nwg = nM * nN; G = G_; c = c_; }
    __host__ __device__ bool next(int i, Unit& u) const { return tile((long)i * G + c, u); }
    __host__ __device__ bool tile(long L, Unit& u) const {
        if (L >= nwg) return false;
        int wgid = (int)L; { const int q = nwg / NXCD, r = nwg % NXCD, xcd = wgid % NXCD, off = wgid / NXCD; wgid = (xcd < r ? xcd * (q + 1) : r * (q + 1) + (xcd - r) * q) + off; }
        const int nig = WGM * nN, gid = wgid / nig, fm = gid * WGM, gsz = (nM - fm) < WGM ? (nM - fm) : WGM;
        u.pm = fm + ((wgid % nig) % gsz); u.pn = (wgid % nig) / gsz; return true;
    }
    __device__ __forceinline__ void a_ready(const Unit&) const {}
    __device__ __forceinline__ void done(const Unit&) const {}
};

struct MixOrder {
    StaticOrder so; int ntag, ntp, S, nts, nN, G, c, npc;
    const char* a0; const char* a1; const char* b0; const char* b1; size_t tA, tB;
    __device__ __forceinline__ void init(int nMp, int nN_, int G_, int c_, int ntag_, int ntp_, int S_, int nts_, const void* A0, const void* B0, const void* A1, const void* B1, int lda, int ldb) {
        so.init(nMp * BM, nN_ * BM, G_, c_); ntag = ntag_; ntp = ntp_; S = S_; nts = nts_; nN = nN_; G = G_; c = c_;
        npc = (so.nwg > c_) ? (so.nwg - 1 - c_) / G_ + 1 : 0;
        a0 = (const char*)A0; a1 = (const char*)A1; b0 = (const char*)B0; b1 = (const char*)B1; tA = (size_t)BM * lda * 2; tB = (size_t)BM * ldb * 2;
    }
    __device__ __forceinline__ bool next(int i, Unit& u) const {
        if (i < npc * ntag) { const int r = i / ntag, tg = i - r * ntag; so.next(r, u); u.tag = tg; u.nt = ntp; u.kq = 0;
            u.a = (tg ? a1 : a0) + (size_t)u.pm * tA; u.b = (tg ? b1 : b0) + (size_t)u.pn * tB; return true; }
        const int j = (i - npc * ntag) * G + c, per = nN * S;
        if (j >= ntag * per) return false;
        const int tg = j / per, rem = j - tg * per, kq = rem / nN; u.pm = 32; u.pn = rem - kq * nN; u.tag = tg | 4; u.nt = nts; u.kq = kq;
        u.a = (tg ? a1 : a0) + (size_t)32 * tA + (size_t)kq * nts * (BK * 2); u.b = (tg ? b1 : b0) + (size_t)u.pn * tB + (size_t)kq * nts * (BK * 2); return true;
    }
    __device__ __forceinline__ void a_ready(const Unit&) const {}
    __device__ __forceinline__ void done(const Unit&) const {}
};

struct GluBOrder {
    StaticOrder sb; int G, c; const char* za; const char* wg; const char* bo; const char* wb; size_t tA, tB;
    __device__ __forceinline__ void init(int G_, int c_, const void* ZA, const void* WG, const void* BO, const void* WB) {
        sb.init(32 * BM, 8 * BM, G_, 0); G = G_; c = c_; za = (const char*)ZA; wg = (const char*)WG; bo = (const char*)BO; wb = (const char*)WB; tA = (size_t)BM * 1024 * 2; tB = tA; }
    __device__ __forceinline__ bool next(int i, Unit& u) const {
        const int L = i * G + c; u.kq = 0; u.pad_ = 0;
        if (L < 132) { u.pm = L >> 2; u.pn = L & 3; u.tag = 0; u.nt = 16; u.a = za + (size_t)u.pm * tA; u.b = wg + (size_t)u.pn * tB; return true; }
        if (L < 388) { sb.tile(L - 132, u); u.tag = 1; u.nt = 16; u.a = bo + (size_t)u.pm * tA; u.b = wb + (size_t)u.pn * tB; return true; }
        const int j = L - 388; if (j >= 32) return false;
        u.kq = j >> 3; u.pn = j & 7; u.pm = 32; u.tag = 5; u.nt = 4; u.a = bo + (size_t)32 * tA + (size_t)u.kq * 4 * (BK * 2); u.b = wb + (size_t)u.pn * tB + (size_t)u.kq * 4 * (BK * 2); return true;
    }
    __device__ __forceinline__ void a_ready(const Unit&) const {}
    __device__ __forceinline__ void done(const Unit&) const {}
};

__device__ __forceinline__ unsigned cvt_pk_bf16(float lo, float hi) { typedef float f2_t __attribute__((ext_vector_type(2))); typedef __bf16 b2_t __attribute__((ext_vector_type(2))); const f2_t v = {lo, hi}; return __builtin_bit_cast(unsigned, __builtin_convertvector(v, b2_t)); }
typedef float f32x2 __attribute__((ext_vector_type(2)));
__device__ __forceinline__ float sigm(float x) { return __builtin_amdgcn_rcpf(1.f + __builtin_amdgcn_exp2f(-1.4426950409f * x)); }
__device__ __forceinline__ float bflo(unsigned w) { return __uint_as_float(w << 16); }
__device__ __forceinline__ float bfhi(unsigned w) { return __uint_as_float(w & 0xffff0000u); }
typedef __amdgpu_buffer_rsrc_t rsrc_t;
__device__ __forceinline__ rsrc_t mkrsrc(const void* base) { return __builtin_amdgcn_make_buffer_rsrc((void*)base, 0, 0x7fffffff, 0x00020000); }
__device__ __forceinline__ void st16wt(rsrc_t r, size_t byteoff, f32x4 v) { __builtin_amdgcn_raw_buffer_store_b128(__builtin_bit_cast(u32x4, v), r, (int)byteoff, 0, 16); }
constexpr int PAD_TILE = 32;
struct EpiSwiglu {
    static constexpr bool PERM = true, AFTER_DRAIN = false;
    bf16_t* H; int ldh; const PG8_LAS _Float16* rsl;
    __device__ __forceinline__ void operator()(const f32x4 (&acc)[2][2][4][2], const Unit& u, int wr, int wc, int fr, int fq) const {
        const int row0 = u.pm * BM + wr * 64 + fr, col0 = u.pn * HALF + wc * 32 + 8 * fq;
#pragma unroll
        for (int ai = 0; ai < 2; ++ai)
#pragma unroll
            for (int m = 0; m < 4; ++m) { bf16_t* rowp = H + (size_t)(row0 + ai * HALF + m * 16) * ldh + col0;
                const float rs = rsl ? (float)rsl[row0 + ai * HALF + m * 16] : 1.0f;
                float v[8];
#pragma unroll
                for (int n = 0; n < 2; ++n)
#pragma unroll
                    for (int e = 0; e < 4; ++e) { const float g = acc[ai][0][m][n][e] * rs, up = acc[ai][1][m][n][e] * rs; v[4 * n + e] = g * up * sigm(g); }
                u32x4 w; w.x = cvt_pk_bf16(v[0], v[1]); w.y = cvt_pk_bf16(v[2], v[3]); w.z = cvt_pk_bf16(v[4], v[5]); w.w = cvt_pk_bf16(v[6], v[7]);
                *(u32x4*)rowp = w; }
    }
};
struct EpiResNorm {
    static constexpr bool PERM = true, AFTER_DRAIN = true;
    const float* baseP; float* out; bf16_t* xn; float* ssq; int ldc; float scale;
    float* slab; const float* baseS; float* outS; unsigned* cnt; unsigned* tmo; int S;
    __device__ __forceinline__ void operator()(const f32x4 (&acc)[2][2][4][2], const Unit& u, int wr, int wc, int fr, int fq) const {
        const int col0 = u.pn * BM + wc * 32 + 8 * fq;
#pragma unroll
        for (int ai = 0; ai < 2; ++ai)
#pragma unroll
            for (int m = 0; m < 4; ++m) { const int row = u.pm * BM + ai * HALF + wr * 64 + m * 16 + fr; const size_t op = (size_t)row * ldc; float sq = 0.f;
#pragma unroll
                for (int bj = 0; bj < 2; ++bj) { const int c = col0 + bj * HALF;
                    const f32x4 o0 = *(const f32x4*)(baseP + op + c) + acc[ai][bj][m][0] * scale, o1 = *(const f32x4*)(baseP + op + c + 4) + acc[ai][bj][m][1] * scale;
                    *(f32x4*)(out + op + c) = o0; *(f32x4*)(out + op + c + 4) = o1;
                    if (xn) { u32x4 w; w.x = cvt_pk_bf16(o0[0], o0[1]); w.y = cvt_pk_bf16(o0[2], o0[3]); w.z = cvt_pk_bf16(o1[0], o1[1]); w.w = cvt_pk_bf16(o1[2], o1[3]); *(u32x4*)(xn + op + c) = w;
                        sq += ((o0[0] * o0[0] + o0[1] * o0[1]) + (o0[2] * o0[2] + o0[3] * o0[3])) + ((o1[0] * o1[0] + o1[1] * o1[1]) + (o1[2] * o1[2] + o1[3] * o1[3])); } }
                if (xn) {
                    { auto r1 = __builtin_amdgcn_permlane16_swap(__float_as_uint(sq), __float_as_uint(sq), false, false); sq = __uint_as_float(r1[0]) + __uint_as_float(r1[1]); }
                    { auto r2 = __builtin_amdgcn_permlane32_swap(__float_as_uint(sq), __float_as_uint(sq), false, false); sq = __uint_as_float(r2[0]) + __uint_as_float(r2[1]); }
                    if (fq == 0) __hip_atomic_fetch_add(ssq + row, sq, __ATOMIC_RELAXED, __HIP_MEMORY_SCOPE_AGENT); } }
    }
    __device__ __forceinline__ void fused(f32x4 (&acc)[2][2][4][2], const Unit& u, int wr, int wc, int fr, int fq, PG8_LAS unsigned char* lds, int wid, int lane) const {
        if (!(u.tag & 4)) { (*this)(acc, u, wr, wc, fr, fq); }
        else {
            const int col0 = u.pn * BM + wc * 32 + 8 * fq; const rsrc_t rs = mkrsrc(slab);
#pragma unroll
            for (int m = 0; m < 4; ++m) { const size_t op = ((size_t)u.kq * HALF + wr * 64 + m * 16 + fr) * ldc + col0;
#pragma unroll
                for (int bj = 0; bj < 2; ++bj) { st16wt(rs, (op + bj * HALF) * 4, acc[0][bj][m][0]); st16wt(rs, (op + bj * HALF + 4) * 4, acc[0][bj][m][1]); } }
            asm volatile("s_waitcnt vmcnt(0)" ::: "memory"); __syncthreads();
            if (threadIdx.x == 0) {
                unsigned* cw = cnt + 64 * u.pn; __hip_atomic_fetch_add(cw, 1u, __ATOMIC_RELAXED, __HIP_MEMORY_SCOPE_AGENT);
                unsigned sp = 0u;
                while (__hip_atomic_load(cw, __ATOMIC_RELAXED, __HIP_MEMORY_SCOPE_AGENT) < (unsigned)S) { __builtin_amdgcn_s_sleep(2);
                    if ((++sp & 255u) == 0u) { if (__hip_atomic_load(tmo, __ATOMIC_RELAXED, __HIP_MEMORY_SCOPE_AGENT)) break; if (sp > (1u << 18)) { __hip_atomic_fetch_add(tmo, 1u, __ATOMIC_RELAXED, __HIP_MEMORY_SCOPE_AGENT); break; } } }
                __builtin_amdgcn_fence(__ATOMIC_ACQUIRE, "agent"); asm volatile("s_waitcnt vmcnt(0)" ::: "memory");
            }
            __syncthreads();
            for (int r = u.kq + S * wid; r < HALF; r += S * 8) {
                const size_t o4 = (size_t)r * ldc + u.pn * BM + 4 * lane; f32x4 a = {0.f, 0.f, 0.f, 0.f};
                for (int k = 0; k < S; ++k) a = a + *(const f32x4*)(slab + (size_t)k * HALF * ldc + o4);
                const f32x4 o = *(const f32x4*)(baseS + o4) + a * scale; *(f32x4*)(outS + o4) = o;
                if (xn) { typedef unsigned u32x2 __attribute__((ext_vector_type(2))); u32x2 w; w.x = cvt_pk_bf16(o[0], o[1]); w.y = cvt_pk_bf16(o[2], o[3]); *(u32x2*)(xn + (size_t)PAD_TILE * BM * ldc + o4) = w;
                    float sq = (o[0] * o[0] + o[1] * o[1]) + (o[2] * o[2] + o[3] * o[3]);
#pragma unroll
                    for (int of = 1; of < 64; of <<= 1) sq += __shfl_xor(sq, of);
                    if (lane == 0) __hip_atomic_fetch_add(ssq + PAD_TILE * BM + r, sq, __ATOMIC_RELAXED, __HIP_MEMORY_SCOPE_AGENT); }
            }
        }
    }
};
struct EpiBf16Plain {
    static constexpr bool PERM = true, AFTER_DRAIN = false;
    bf16_t* O; int ldc; const PG8_LAS _Float16* rsl;
    __device__ __forceinline__ void operator()(const f32x4 (&acc)[2][2][4][2], const Unit& u, int wr, int wc, int fr, int fq) const {
        const int row0 = u.pm * BM + wr * 64 + fr, col0 = u.pn * BM + wc * 32 + 8 * fq;
#pragma unroll
        for (int ai = 0; ai < 2; ++ai)
#pragma unroll
            for (int m = 0; m < 4; ++m) { bf16_t* rowp = O + (size_t)(row0 + ai * HALF + m * 16) * ldc + col0;
                const float rs = rsl ? (float)rsl[row0 + ai * HALF + m * 16] : 1.0f;
#pragma unroll
                for (int bj = 0; bj < 2; ++bj) { const f32x4 v0 = acc[ai][bj][m][0] * rs, v1 = acc[ai][bj][m][1] * rs;
                    u32x4 w; w.x = cvt_pk_bf16(v0[0], v0[1]); w.y = cvt_pk_bf16(v0[2], v0[3]); w.z = cvt_pk_bf16(v1[0], v1[1]); w.w = cvt_pk_bf16(v1[2], v1[3]);
                    *(u32x4*)(rowp + bj * HALF) = w; } }
    }
};
struct EpiGluB {
    static constexpr bool PERM = true, AFTER_DRAIN = false;
    bf16_t* AO; const bf16_t* ZA; const float* bias; bf16_t* T; const bf16_t* GB; int ldg; float* PBs;
    __device__ __forceinline__ void operator()(const f32x4 (&acc)[2][2][4][2], const Unit& u, int wr, int wc, int fr, int fq) const {
        const int row0 = u.pm * BM + wr * 64 + fr, col0 = u.pn * BM + wc * 32 + 8 * fq;
        if (u.tag & 4) { float* dst = PBs + (size_t)u.kq * HALF * 2048;
#pragma unroll
            for (int m = 0; m < 4; ++m) { float* op = dst + (size_t)(wr * 64 + m * 16 + fr) * 2048 + col0;
#pragma unroll
                for (int bj = 0; bj < 2; ++bj)
#pragma unroll
                    for (int n = 0; n < 2; ++n) *(f32x4*)(op + bj * HALF + 4 * n) = acc[0][bj][m][n]; }
        } else {
        const bool glu = u.tag == 0; const bf16_t* G = glu ? ZA : GB; const int ld = glu ? 1024 : ldg, ldo = glu ? 1024 : 2048;
#pragma unroll
        for (int ai = 0; ai < 2; ++ai)
#pragma unroll
            for (int m = 0; m < 4; ++m) { const size_t row = (size_t)(row0 + ai * HALF + m * 16);
#pragma unroll
                for (int bj = 0; bj < 2; ++bj) { const int c = col0 + bj * HALF; float o[8];
                    const u32x4 gw = *(const u32x4*)(G + row * ld + c);
                    const float g[8] = {bflo(gw.x), bfhi(gw.x), bflo(gw.y), bfhi(gw.y), bflo(gw.z), bfhi(gw.z), bflo(gw.w), bfhi(gw.w)};
                    if (glu) { const f32x4 b0 = *(const f32x4*)(bias + c), b1 = *(const f32x4*)(bias + c + 4);
#pragma unroll
                        for (int e = 0; e < 4; ++e) { o[e] = g[e] * sigm(acc[ai][bj][m][0][e] + b0[e]); o[4 + e] = g[4 + e] * sigm(acc[ai][bj][m][1][e] + b1[e]); } }
                    else {
#pragma unroll
                        for (int e = 0; e < 4; ++e) { o[e] = sigm(g[e]) * acc[ai][bj][m][0][e]; o[4 + e] = sigm(g[4 + e]) * acc[ai][bj][m][1][e]; } }
                    u32x4 w; w.x = cvt_pk_bf16(o[0], o[1]); w.y = cvt_pk_bf16(o[2], o[3]); w.z = cvt_pk_bf16(o[4], o[5]); w.w = cvt_pk_bf16(o[6], o[7]);
                    if (glu) *(u32x4*)(AO + row * ldo + c) = w; else *(u32x4*)(T + row * ldo + c) = w; } }
        }
    }
};
struct EpiBranchA {
    static constexpr bool PERM = true, AFTER_DRAIN = false;
    const bf16_t* T; bf16_t* MG; int ldo; const bf16_t* GA; int ldg; float* PAs;
    __device__ __forceinline__ void operator()(const f32x4 (&acc)[2][2][4][2], const Unit& u, int wr, int wc, int fr, int fq) const {
        const int row0 = u.pm * BM + wr * 64 + fr, col0 = u.pn * BM + wc * 32 + 8 * fq;
        if (u.tag & 4) { float* dst = PAs + (size_t)u.kq * HALF * ldo;
#pragma unroll
            for (int m = 0; m < 4; ++m) { float* op = dst + (size_t)(wr * 64 + m * 16 + fr) * ldo + col0;
#pragma unroll
                for (int bj = 0; bj < 2; ++bj)
#pragma unroll
                    for (int n = 0; n < 2; ++n) *(f32x4*)(op + bj * HALF + 4 * n) = acc[0][bj][m][n]; }
        } else {
#pragma unroll
        for (int ai = 0; ai < 2; ++ai)
#pragma unroll
            for (int m = 0; m < 4; ++m) { const size_t row = (size_t)(row0 + ai * HALF + m * 16);
#pragma unroll
                for (int bj = 0; bj < 2; ++bj) { const int c = col0 + bj * HALF; float o[8];
                    const u32x4 gw = *(const u32x4*)(GA + row * ldg + c), pw = *(const u32x4*)(T + row * ldo + c);
                    const float g[8] = {bflo(gw.x), bfhi(gw.x), bflo(gw.y), bfhi(gw.y), bflo(gw.z), bfhi(gw.z), bflo(gw.w), bfhi(gw.w)};
                    const float p[8] = {bflo(pw.x), bfhi(pw.x), bflo(pw.y), bfhi(pw.y), bflo(pw.z), bfhi(pw.z), bflo(pw.w), bfhi(pw.w)};
#pragma unroll
                    for (int e = 0; e < 4; ++e) { o[e] = p[e] + sigm(g[e]) * acc[ai][bj][m][0][e]; o[4 + e] = p[4 + e] + sigm(g[4 + e]) * acc[ai][bj][m][1][e]; }
                    u32x4 w; w.x = cvt_pk_bf16(o[0], o[1]); w.y = cvt_pk_bf16(o[2], o[3]); w.z = cvt_pk_bf16(o[4], o[5]); w.w = cvt_pk_bf16(o[6], o[7]);
                    *(u32x4*)(MG + row * ldo + c) = w; } }
        }
    }
};
template <class Epi, class Sched, bool ALIGN_EPI = false, bool SP2 = false>
__device__ __forceinline__ void gemm_phase(PG8_LAS unsigned char* lds, const Gemm g, const Sched& S, const Epi& E) {
    const int tid = threadIdx.x, wid = __builtin_amdgcn_readfirstlane(tid >> 6), lane = tid & 63, wr = wid >> 2, wc = wid & 3, fr = lane & 15, fq = lane >> 4;
    unsigned voffA[2], voffB[2];
#pragma unroll
    for (int i = 0; i < 2; ++i) { int R, C; stage_rc(tid * 16 + i * 8192, R, C); const int Rb = Epi::PERM ? ((R & ~31) + perm32(R & 31)) : R;
        voffA[i] = (unsigned)(R * g.lda + C) * 2u; voffB[i] = (unsigned)(Rb * g.ldb + C) * 2u; }
    const size_t kstep = (size_t)(BK * 2);
    const size_t hstepA = (size_t)HALF * g.lda * 2, hstepB = (size_t)HALF * g.ldb * 2;
    const unsigned ldsw = (unsigned)wid * 1024u;
    const int aoff = lds_byte(wr * 64 + fr, fq * 8), boff = lds_byte(wc * 32 + fr, fq * 8);
#define PG8_SA(b, h) (((b) * 2 + (h)) * HTB)
#define PG8_SB(b, h) ((4 + (b) * 2 + (h)) * HTB)
#define PG8_STAGE(bufoff, gbase, voff) do { _Pragma("unroll") for (int _i = 0; _i < 2; ++_i) \
        __builtin_amdgcn_global_load_lds((const unsigned*)((const char*)(gbase) + (voff)[_i]), (PG8_LAS unsigned*)(lds + (bufoff) + ldsw + _i * 8192), 16, 0, 0); } while (0)
#define PG8_LDA(dst, b, h) do { _Pragma("unroll") for (int m = 0; m < 4; ++m) _Pragma("unroll") for (int k = 0; k < 2; ++k) dst[m][k] = *(const PG8_LAS bf16x8*)(lds + PG8_SA(b, h) + aoff + m * 2048 + k * 1024); } while (0)
#define PG8_LDB(dst, b, h) do { _Pragma("unroll") for (int n = 0; n < 2; ++n) _Pragma("unroll") for (int k = 0; k < 2; ++k) dst[n][k] = *(const PG8_LAS bf16x8*)(lds + PG8_SB(b, h) + boff + n * 2048 + k * 1024); } while (0)
#define PG8_MMA(ai, bj, At, Bt) do { __builtin_amdgcn_s_setprio(1); _Pragma("unroll") for (int m = 0; m < 4; ++m) _Pragma("unroll") for (int n = 0; n < 2; ++n) _Pragma("unroll") for (int k = 0; k < 2; ++k) \
        acc[ai][bj][m][n] = __builtin_amdgcn_mfma_f32_16x16x32_bf16(Bt[n][k], At[m][k], acc[ai][bj][m][n], 0, 0, 0); __builtin_amdgcn_s_setprio(0); } while (0)
#define PG8_WAIT_V(n) asm volatile("s_waitcnt vmcnt(" #n ")" ::: "memory")
#define PG8_WAIT_L(n) asm volatile("s_waitcnt lgkmcnt(" #n ")" ::: "memory")
#define PG8_BAR __builtin_amdgcn_s_barrier()
#define PG8_SCHED __builtin_amdgcn_sched_barrier(0)
    Unit cur, nxt; int ui = 0;
    if (!S.next(0, cur)) return;
    f32x4 acc[2][2][4][2];
#pragma unroll
    for (int a = 0; a < 2; ++a)
#pragma unroll
        for (int b = 0; b < 2; ++b)
#pragma unroll
            for (int m = 0; m < 4; ++m)
#pragma unroll
                for (int n = 0; n < 2; ++n) acc[a][b][m][n] = (f32x4){0.f, 0.f, 0.f, 0.f};
    bf16x8 At[4][2], B0[2][2], B1[2][2];
    const char* cA = cur.a; const char* cB = cur.b;
    S.a_ready(cur);
    if constexpr (SP2) {
        PG8_STAGE(PG8_SB(0, 0), cB, voffB); PG8_STAGE(PG8_SB(0, 1), cB + hstepB, voffB); PG8_STAGE(PG8_SA(0, 0), cA, voffA); PG8_STAGE(PG8_SA(0, 1), cA + hstepA, voffA);
        if (wr == 1) PG8_BAR;
        PG8_WAIT_V(2); PG8_BAR;
        PG8_STAGE(PG8_SB(1, 0), cB + kstep, voffB); PG8_STAGE(PG8_SA(1, 0), cA + kstep, voffA); PG8_STAGE(PG8_SB(1, 1), cB + hstepB + kstep, voffB);
        PG8_WAIT_V(6); PG8_BAR;
    } else {
        PG8_STAGE(PG8_SB(0, 0), cB, voffB); PG8_STAGE(PG8_SA(0, 0), cA, voffA); PG8_STAGE(PG8_SB(0, 1), cB + hstepB, voffB); PG8_STAGE(PG8_SA(0, 1), cA + hstepA, voffA);
        if (wr == 1) PG8_BAR;
        PG8_WAIT_V(4); PG8_BAR;
        PG8_STAGE(PG8_SB(1, 0), cB + kstep, voffB); PG8_STAGE(PG8_SA(1, 0), cA + kstep, voffA); PG8_STAGE(PG8_SB(1, 1), cB + hstepB + kstep, voffB);
        PG8_WAIT_V(6); PG8_BAR;
    }
    for (;;) {
        const bool has_next = S.next(ui + 1, nxt);
        const char* nA = has_next ? nxt.a : cA; const char* nB = has_next ? nxt.b : cB; const int nt = cur.nt;
        for (int t = 0; t < nt; t += 2) {
            const bool last = (t == nt - 2);
            const char* a1 = cA + (size_t)(t + 1) * kstep;
            const char* a2 = last ? nA : cA + (size_t)(t + 2) * kstep; const char* b2 = last ? nB : cB + (size_t)(t + 2) * kstep;
            const char* a3 = a2 + kstep; const char* b3 = b2 + kstep;
            if (last && has_next) S.a_ready(nxt);
            if constexpr (SP2) {
            PG8_LDB(B0, 0, 0); PG8_LDB(B1, 0, 1); PG8_SCHED; PG8_LDA(At, 0, 0); PG8_STAGE(PG8_SA(1, 1), a1 + hstepA, voffA);
            PG8_WAIT_V(8); PG8_WAIT_L(0); PG8_BAR; PG8_MMA(0, 0, At, B0); PG8_MMA(0, 1, At, B1); PG8_BAR; PG8_SCHED;
            PG8_LDA(At, 0, 1); PG8_STAGE(PG8_SB(0, 0), b2, voffB); PG8_STAGE(PG8_SB(0, 1), b2 + hstepB, voffB); PG8_STAGE(PG8_SA(0, 0), a2, voffA);
            PG8_WAIT_V(8); PG8_WAIT_L(0); PG8_BAR; PG8_MMA(1, 0, At, B0); PG8_MMA(1, 1, At, B1); PG8_BAR; PG8_SCHED;
            PG8_LDB(B0, 1, 0); PG8_LDB(B1, 1, 1); PG8_SCHED; PG8_LDA(At, 1, 0); PG8_STAGE(PG8_SA(0, 1), a2 + hstepA, voffA);
            PG8_WAIT_V(8); PG8_WAIT_L(0); PG8_BAR; PG8_MMA(0, 0, At, B0); PG8_MMA(0, 1, At, B1); PG8_BAR; PG8_SCHED;
            PG8_LDA(At, 1, 1); PG8_STAGE(PG8_SB(1, 0), b3, voffB); PG8_STAGE(PG8_SB(1, 1), b3 + hstepB, voffB); PG8_STAGE(PG8_SA(1, 0), a3, voffA);
            PG8_WAIT_V(8); PG8_WAIT_L(0); PG8_BAR; PG8_MMA(1, 0, At, B0); PG8_MMA(1, 1, At, B1); PG8_BAR; PG8_SCHED;
            } else {
            PG8_LDB(B0, 0, 0); PG8_SCHED; PG8_LDA(At, 0, 0); PG8_STAGE(PG8_SA(1, 1), a1 + hstepA, voffA);
            PG8_WAIT_L(8); PG8_BAR; PG8_WAIT_L(0); PG8_MMA(0, 0, At, B0); PG8_BAR; PG8_SCHED;
            PG8_LDB(B1, 0, 1); PG8_STAGE(PG8_SB(0, 0), b2, voffB);
            PG8_BAR; PG8_WAIT_L(0); PG8_MMA(0, 1, At, B1); PG8_BAR;
            PG8_LDA(At, 0, 1); PG8_STAGE(PG8_SA(0, 0), a2, voffA);
            PG8_BAR; PG8_WAIT_L(0); PG8_MMA(1, 0, At, B0); PG8_BAR; PG8_SCHED;
            PG8_STAGE(PG8_SB(0, 1), b2 + hstepB, voffB);
            PG8_WAIT_V(6); PG8_BAR; PG8_MMA(1, 1, At, B1); PG8_BAR;
            PG8_LDB(B0, 1, 0); PG8_SCHED; PG8_LDA(At, 1, 0); PG8_STAGE(PG8_SA(0, 1), a2 + hstepA, voffA);
            PG8_WAIT_L(8); PG8_BAR; PG8_WAIT_L(0); PG8_MMA(0, 0, At, B0); PG8_BAR; PG8_SCHED;
            PG8_LDB(B1, 1, 1); PG8_STAGE(PG8_SB(1, 0), b3, voffB);
            PG8_BAR; PG8_WAIT_L(0); PG8_MMA(0, 1, At, B1); PG8_BAR;
            PG8_LDA(At, 1, 1); PG8_STAGE(PG8_SA(1, 0), a3, voffA);
            PG8_BAR; PG8_WAIT_L(0); PG8_MMA(1, 0, At, B0); PG8_BAR; PG8_SCHED;
            PG8_STAGE(PG8_SB(1, 1), b3 + hstepB, voffB);
            PG8_WAIT_V(6); PG8_BAR; PG8_MMA(1, 1, At, B1); PG8_BAR;
            }
        }
        if constexpr (ALIGN_EPI) { if (wr == 0) PG8_BAR; }
        if constexpr (!Epi::AFTER_DRAIN) { E(acc, cur, wr, wc, fr, fq); S.done(cur); }
        else { if (has_next) { E(acc, cur, wr, wc, fr, fq); S.done(cur); } }
        if (!has_next) break;
#pragma unroll
        for (int a = 0; a < 2; ++a)
#pragma unroll
            for (int b = 0; b < 2; ++b)
#pragma unroll
                for (int m = 0; m < 4; ++m)
#pragma unroll
                    for (int n = 0; n < 2; ++n) acc[a][b][m][n] = (f32x4){0.f, 0.f, 0.f, 0.f};
        cur = nxt; cA = nA; cB = nB; ++ui;
        if constexpr (ALIGN_EPI) { if (wr == 1) PG8_BAR; }
    }
    PG8_WAIT_V(0);
    if constexpr (!ALIGN_EPI) { if (wr == 0) PG8_BAR; }
    PG8_BAR;
    if constexpr (Epi::AFTER_DRAIN) { E.fused(acc, cur, wr, wc, fr, fq, lds, wid, lane); S.done(cur); }
#undef PG8_SA
#undef PG8_SB
#undef PG8_STAGE
#undef PG8_LDA
#undef PG8_LDB
#undef PG8_MMA
#undef PG8_WAIT_V
#undef PG8_WAIT_L
#undef PG8_BAR
#undef PG8_SCHED
}
}

constexpr int NWAVES = 8;
constexpr int D = 2048, NBATCH = 4, SEQ = 2048, MP = NBATCH * SEQ;
constexpr int DBATCH = 32, DSEQ = 4, MS = DBATCH * DSEQ;
constexpr int MR = MP + MS, MPAD = 8448;
constexpr int FF = 5632, NGU = 2 * FF;
constexpr int NIN = 7760, NINP = 7936;
constexpr int ZU = 0, ZQ = 1024, ZK = 2048, ZV = 2304, ZQI = 2560, ZKI = 3584, ZWI = 3648, ZGA = 3664, ZGB = 5712;
constexpr int PAST = 8192, NPAGES = 64, LTOT = PAST + DSEQ, SSCLD = 8448;
constexpr float EPS = 1e-6f;
constexpr float QSCALE = 0.08838834764831845f * 1.4426950408889634f;
constexpr size_t O_YP = 0, O_YS = 16777216, O_KP = 17039360, O_VP = 19136512, O_IKP = 21233664, O_SRP = 21757952, O_SIP = 21774336,
                 O_KS = 21790720, O_VS = 21823488, O_IKS = 21856256, O_SRS = 21864448, O_SIS = 21995520, O_END = 22126592;
constexpr size_t MiB = 1u << 20;
constexpr size_t WS_CTL = 0, CTL_ZERO_BYTES = 1 * MiB;
constexpr size_t WS_W1GU = 1 * MiB, WS_W1D = WS_W1GU + 44 * MiB, WS_W2GU = WS_W1D + 22 * MiB, WS_W2D = WS_W2GU + 44 * MiB, WS_WIN = WS_W2D + 22 * MiB,
                 WS_WGLU = WS_WIN + 31 * MiB, WS_WA = WS_WGLU + 2 * MiB, WS_WB = WS_WA + 4 * MiB, WS_WOUT = WS_WB + 4 * MiB,
                 WS_XN = WS_WOUT + 8 * MiB, WS_H = WS_XN + 33 * MiB, WS_X1 = WS_H + 91 * MiB, WS_X2 = WS_X1 + 66 * MiB, WS_Z = WS_X2 + 66 * MiB,
                 WS_QB = WS_Z + 128 * MiB, WS_QIB = WS_QB + 17 * MiB, WS_ZA = WS_QIB + 17 * MiB, WS_AOUT = WS_ZA + 17 * MiB, WS_BOUT = WS_AOUT + 17 * MiB,
                 WS_KB = WS_BOUT + 17 * MiB, WS_VT = WS_KB + 5 * MiB, WS_KIB = WS_VT + 4 * MiB, WS_WIF = WS_KIB + 2 * MiB, WS_MASK = WS_WIF + 1 * MiB,
                 WS_SSC = WS_MASK + 2 * MiB, WS_TMPG = WS_SSC + 5 * MiB, WS_MERGED = WS_TMPG + 33 * MiB, WS_SSMP = WS_MERGED + 33 * MiB, WS_PAS = WS_SSMP + 2 * MiB, WS_PBS = WS_PAS + 4 * MiB, WS_SLAB = WS_PBS + 4 * MiB, WS_SLAB2 = WS_SLAB + 23 * MiB, WS_SLAB3 = WS_SLAB2 + 9 * MiB, WS_END = WS_SLAB3 + 23 * MiB;
constexpr size_t SSMP_LAMB = 0, SSMP_BT = 64 * 1024, SSMP_CT = SSMP_BT + 256 * 1024, SSMP_BBF = SSMP_CT + 256 * 1024;
constexpr int CW_BAR = 4096, CW_CNT = 8192, CW_SSQ1 = 32768, CW_SSQ2 = 49152;
constexpr int LDS_MISC = 151552;
constexpr int LDS_BYTES = 151552 + 256;
constexpr int SSM_WPITCH = 272, SSM_WBYTES = 32 * SSM_WPITCH, SSM_UOFF = 8 * SSM_WBYTES, SSM_EOFF = SSM_UOFF + 8 * 1024;

#define GAS __attribute__((address_space(1)))
#define LAS __attribute__((address_space(3)))
typedef unsigned short bf16;
typedef unsigned v4u __attribute__((ext_vector_type(4)));
typedef unsigned v2u __attribute__((ext_vector_type(2)));
typedef float f32x4 __attribute__((ext_vector_type(4)));
typedef float f32x16 __attribute__((ext_vector_type(16)));
typedef short bf16x8 __attribute__((ext_vector_type(8)));
#define LDS_WAIT() asm volatile("s_waitcnt lgkmcnt(0)" ::: "memory")
#define VM_WAIT() asm volatile("s_waitcnt vmcnt(0)" ::: "memory")
#define MFMA32(a, b, c) __builtin_amdgcn_mfma_f32_32x32x16_bf16((a), (b), (c), 0, 0, 0)
__device__ __forceinline__ unsigned f2bf(float f) { unsigned u = __builtin_bit_cast(unsigned, f); return (u + 0x7fffu + ((u >> 16) & 1u)) >> 16; }
typedef float f32x2_t __attribute__((ext_vector_type(2))); typedef __bf16 bf16x2_t __attribute__((ext_vector_type(2)));
__device__ __forceinline__ unsigned pk2(float lo, float hi) { const f32x2_t v = {lo, hi}; const bf16x2_t b = __builtin_convertvector(v, bf16x2_t); return __builtin_bit_cast(unsigned, b); }
__device__ __forceinline__ float bf2f(unsigned short h) { return __uint_as_float(((unsigned)h) << 16); }
__device__ __forceinline__ float blo(unsigned w) { return __uint_as_float(w << 16); }
__device__ __forceinline__ float bhi(unsigned w) { return __uint_as_float(w & 0xffff0000u); }
__device__ __forceinline__ float wave_sum(float v) {
#pragma unroll
    for (int o = 1; o < 64; o <<= 1) v += __shfl_xor(v, o);
    return v;
}
__device__ __forceinline__ float wave_max(float v) {
#pragma unroll
    for (int o = 1; o < 64; o <<= 1) v = fmaxf(v, __shfl_xor(v, o));
    return v;
}
__device__ __forceinline__ float swap32_max(float x) { auto rr = __builtin_amdgcn_permlane32_swap(__float_as_uint(x), __float_as_uint(x), false, false); return fmaxf(__uint_as_float(rr[0]), __uint_as_float(rr[1])); }
__device__ __forceinline__ float swap32_sum(float x) { auto rr = __builtin_amdgcn_permlane32_swap(__float_as_uint(x), __float_as_uint(x), false, false); return __uint_as_float(rr[0]) + __uint_as_float(rr[1]); }
#define DPP_I(v, ctrl) __builtin_amdgcn_update_dpp(0, (v), (ctrl), 0xF, 0xF, true)
#define DPP_F(v, ctrl) __int_as_float(__builtin_amdgcn_update_dpp(0, __float_as_int(v), (ctrl), 0xF, 0xF, true))
__device__ __forceinline__ int half_sum_i(int v) {
    v += DPP_I(v, 0xB1); v += DPP_I(v, 0x4E); v += DPP_I(v, 0x141); v += DPP_I(v, 0x140);
    auto rr = __builtin_amdgcn_permlane16_swap((unsigned)v, (unsigned)v, false, false); return (int)rr[0] + (int)rr[1];
}
__device__ __forceinline__ float half_sum_f(float v) {
    v += DPP_F(v, 0xB1); v += DPP_F(v, 0x4E); v += DPP_F(v, 0x141); v += DPP_F(v, 0x140);
    auto rr = __builtin_amdgcn_permlane16_swap(__float_as_uint(v), __float_as_uint(v), false, false); return __uint_as_float(rr[0]) + __uint_as_float(rr[1]);
}
__device__ __forceinline__ float half_min_f(float v) {
    v = fminf(v, DPP_F(v, 0xB1)); v = fminf(v, DPP_F(v, 0x4E)); v = fminf(v, DPP_F(v, 0x141)); v = fminf(v, DPP_F(v, 0x140));
    auto rr = __builtin_amdgcn_permlane16_swap(__float_as_uint(v), __float_as_uint(v), false, false); return fminf(__uint_as_float(rr[0]), __uint_as_float(rr[1]));
}
__device__ __forceinline__ float half_max_f(float v) {
    v = fmaxf(v, DPP_F(v, 0xB1)); v = fmaxf(v, DPP_F(v, 0x4E)); v = fmaxf(v, DPP_F(v, 0x141)); v = fmaxf(v, DPP_F(v, 0x140));
    auto rr = __builtin_amdgcn_permlane16_swap(__float_as_uint(v), __float_as_uint(v), false, false); return fmaxf(__uint_as_float(rr[0]), __uint_as_float(rr[1]));
}
__device__ __forceinline__ int wsum_i(int v) { v = half_sum_i(v); auto rr = __builtin_amdgcn_permlane32_swap((unsigned)v, (unsigned)v, false, false); return (int)rr[0] + (int)rr[1]; }
__device__ __forceinline__ float wsum_f(float v) { v = half_sum_f(v); auto rr = __builtin_amdgcn_permlane32_swap(__float_as_uint(v), __float_as_uint(v), false, false); return __uint_as_float(rr[0]) + __uint_as_float(rr[1]); }
__device__ __forceinline__ float wmin_f(float v) { v = half_min_f(v); auto rr = __builtin_amdgcn_permlane32_swap(__float_as_uint(v), __float_as_uint(v), false, false); return fminf(__uint_as_float(rr[0]), __uint_as_float(rr[1])); }
__device__ __forceinline__ float wmax_f(float v) { v = half_max_f(v); auto rr = __builtin_amdgcn_permlane32_swap(__float_as_uint(v), __float_as_uint(v), false, false); return fmaxf(__uint_as_float(rr[0]), __uint_as_float(rr[1])); }
__device__ __forceinline__ long long readlane64(long long v, int l) { const int lo = __builtin_amdgcn_readlane((int)v, l), hi = __builtin_amdgcn_readlane((int)(v >> 32), l); return (long long)(((unsigned long long)(unsigned)hi << 32) | (unsigned)lo); }
#define LANE_F(v, l) __int_as_float(__builtin_amdgcn_readlane(__float_as_int(v), (l)))
__device__ __forceinline__ void sincos_acc(float ang, float& s, float& c) {
    double rev = (double)ang * 0.15915494309189535; rev -= __builtin_rint(rev);
    const float r = (float)rev; s = __builtin_amdgcn_sinf(r); c = __builtin_amdgcn_cosf(r);
}
__device__ __forceinline__ float gelu_tanh(float x) { const float a = 0.7978845608028654f * (x + 0.044715f * x * x * x); return x * __builtin_amdgcn_rcpf(1.f + __builtin_amdgcn_exp2f(-2.f * 1.4426950409f * a)); }
__device__ __forceinline__ unsigned sortable(float x) { const unsigned u = __float_as_uint(x); return (u & 0x80000000u) ? ~u : (u | 0x80000000u); }
__device__ const float ROPE_FQ[24] = { 1.f, 0.440366596f, 0.193922743f, 0.0853971019f, 0.0376060307f, 0.016560439f, 0.00729266461f, 0.00321144587f, 0.00141421356f, 0.000622772379f, 0.000274248188f, 0.000120769735f, 5.3182961e-05f, 2.34199997e-05f, 1.03133862e-05f, 4.54167048e-06f, 1.f, 0.193922743f, 0.0376060307f, 0.00729266461f, 0.00141421356f, 0.000274248188f, 5.3182961e-05f, 1.03133862e-05f };

struct Args {
    const float* in[33]; float* out; unsigned char* ws; int ph_lo, ph_hi;
};
struct Frame {
    LAS unsigned char* lds; volatile LAS unsigned* MISC; unsigned* ctl;
    int tid, lane, wave, vcu, G, gw, NGW;
    const float* const* in; float* out; unsigned char* ws;
};
#define WSP(T, off) ((T*)(F.ws + (off)))
#define XB_TMO      128
#define XB_XCNT(j)  (256  + 64 * (j))
#define XB_XSUB(j)  (1280 + 64 * (j))
#define XB_XGEN(j)  (2304 + 64 * (j))
#define XB_TOP      3328
#define XB_TOPGEN   3392
#define XCD_BAR_WORDS 3456
#define XB_SPIN_CAP (1u << 18)

__device__ __forceinline__ unsigned xb_ld(unsigned* p)              { return __hip_atomic_load(p, __ATOMIC_RELAXED, __HIP_MEMORY_SCOPE_AGENT); }
__device__ __forceinline__ unsigned xb_add(unsigned* p, unsigned v) { return __hip_atomic_fetch_add(p, v, __ATOMIC_RELAXED, __HIP_MEMORY_SCOPE_AGENT); }
__device__ __forceinline__ unsigned xb_xcc_id() { return (unsigned)__builtin_amdgcn_s_getreg((3 << 11) | 20) & 0xFu; }
#define XB_SPIN(cond, bar) do { unsigned _sp = 0; while (cond) { __builtin_amdgcn_s_sleep(1); \
    if ((++_sp & 255u) == 0u) { if (xb_ld(&(bar)[XB_TMO])) break; if (_sp > XB_SPIN_CAP) { atomicAdd(&(bar)[XB_TMO], 1u); break; } } } } while (0)

struct XcdBarrier {
    unsigned* bar; unsigned x;
    volatile LAS unsigned* st;
};

__device__ __forceinline__ XcdBarrier xcd_barrier_post(unsigned* bar, volatile LAS unsigned* st) {
    XcdBarrier b; b.bar = bar; b.x = xb_xcc_id(); b.st = st;
    if (threadIdx.x == 0) (void)xb_add(&bar[XB_XCNT(b.x)], 1u);
    return b;
}
__device__ __forceinline__ void xcd_barrier_complete(unsigned* bar, unsigned x, unsigned& nloc, unsigned& nx) {
    const unsigned G = gridDim.x * gridDim.y * gridDim.z;
    unsigned sum, cnt, mine, sp = 0u;
    for (;;) {
        sum = 0u; cnt = 0u; mine = 0u;
#pragma unroll
        for (unsigned j = 0; j < 16; ++j) { const unsigned c = xb_ld(&bar[XB_XCNT(j)]); sum += c; cnt += (c > 0u) ? 1u : 0u; mine = (j == x) ? c : mine; }
        if (sum == G) break;
        __builtin_amdgcn_s_sleep(1);
        if ((++sp & 255u) == 0u) { if (xb_ld(&bar[XB_TMO])) break; if (sp > XB_SPIN_CAP) { atomicAdd(&bar[XB_TMO], 1u); break; } }
    }
    nloc = mine > 0u ? mine : 1u; nx = cnt > 0u ? cnt : 1u;
}

__device__ __forceinline__ void xcd_barrier(const XcdBarrier& b) {
    asm volatile("s_waitcnt vmcnt(0)" ::: "memory");
    __syncthreads();
    if (threadIdx.x == 0) {
        unsigned* bar = b.bar;
        __builtin_amdgcn_s_waitcnt(0);
        unsigned nloc = b.st[0], nx = b.st[1];
        if (nloc == 0u) { xcd_barrier_complete(bar, b.x, nloc, nx); b.st[0] = nloc; b.st[1] = nx; }
        const unsigned old = xb_add(&bar[XB_XSUB(b.x)], 1u);
        const unsigned gen = old / nloc;
        if (old + 1u == (gen + 1u) * nloc) {
            __builtin_amdgcn_fence(__ATOMIC_RELEASE, "agent");
            asm volatile("s_waitcnt vmcnt(0)" ::: "memory");
            const unsigned og = xb_add(&bar[XB_TOP], 1u);
            const unsigned tg = og / nx;
            if (og + 1u == (tg + 1u) * nx) xb_add(&bar[XB_TOPGEN], 1u);
            else XB_SPIN(xb_ld(&bar[XB_TOPGEN]) == tg, bar);
            __builtin_amdgcn_fence(__ATOMIC_ACQUIRE, "agent");
            xb_add(&bar[XB_XGEN(b.x)], 1u);
            asm volatile("s_waitcnt vmcnt(0)" ::: "memory");
        } else {
            XB_SPIN(xb_ld(&bar[XB_XGEN(b.x)]) == gen, bar);
            __builtin_amdgcn_fence(__ATOMIC_ACQUIRE, "agent");
            asm volatile("s_waitcnt vmcnt(0)" ::: "memory");
        }
    }
    __syncthreads();
}

__device__ __forceinline__ void transpose_item(const float* W, int K, int N, bf16* WT, int kb, int nb, int dst_row0, LAS float* scr, int lane, const float* gain = nullptr) {
    const int k0 = 64 * kb, n0 = 64 * nb; const int nn = n0 + lane;
    float tv[64];
#pragma unroll
    for (int i = 0; i < 64; ++i) tv[i] = (nn < N) ? W[(size_t)(k0 + i) * N + nn] : 0.f;
#pragma unroll
    for (int i = 0; i < 64; ++i) scr[i * 65 + lane] = gain ? tv[i] * gain[k0 + i] : tv[i];
    LDS_WAIT(); asm volatile("" ::: "memory");
    const int c = lane & 7;
#pragma unroll
    for (int j = 0; j < 8; ++j) { const int n = (lane >> 3) + 8 * j; const LAS float* s = scr + (8 * c) * 65 + n;
        v4u o; o.x = pk2(s[0 * 65], s[1 * 65]); o.y = pk2(s[2 * 65], s[3 * 65]); o.z = pk2(s[4 * 65], s[5 * 65]); o.w = pk2(s[6 * 65], s[7 * 65]);
        if (n0 + n < N) *(GAS v4u*)(WT + (size_t)(dst_row0 + n) * K + k0 + 8 * c) = o; }
    LDS_WAIT(); asm volatile("" ::: "memory");
}
__device__ __forceinline__ void rms_row_to_bf16(const float* xrow, const float* gain, bf16* orow, float* copy, const float* slab, int nslab, float scale, int lane) {
    const GAS f32x4* xr = (const GAS f32x4*)xrow + lane; const GAS f32x4* gr = (const GAS f32x4*)gain + lane;
    f32x4 v[8];
#pragma unroll
    for (int j = 0; j < 8; ++j) v[j] = xr[64 * j];
    for (int k = 0; k < nslab; ++k) {
        const GAS f32x4* sr = (const GAS f32x4*)(slab + (size_t)k * 128 * D) + lane;
#pragma unroll
        for (int j = 0; j < 8; ++j) v[j] = v[j] + sr[64 * j] * scale; }
    float s = 0.f;
#pragma unroll
    for (int j = 0; j < 8; ++j) s += (v[j].x * v[j].x + v[j].y * v[j].y) + (v[j].z * v[j].z + v[j].w * v[j].w);
    if (copy) {
#pragma unroll
        for (int j = 0; j < 8; ++j) ((GAS f32x4*)copy + lane)[64 * j] = v[j]; }
    const float r = 1.0f / sqrtf(wave_sum(s) * (1.f / D) + EPS);
    GAS v2u* o8 = (GAS v2u*)orow + lane;
#pragma unroll
    for (int j = 0; j < 8; ++j) { const f32x4 g = gr[64 * j]; v2u w; w.x = pk2(v[j].x * r * g.x, v[j].y * r * g.y); w.y = pk2(v[j].z * r * g.z, v[j].w * r * g.w); o8[64 * j] = w; }
}
__device__ __forceinline__ void zero_fill16(Frame& F, void* p, size_t bytes) {
    GAS v4u* q = (GAS v4u*)p; const size_t n = bytes / 16, T = (size_t)F.NGW * 64;
    for (size_t i = (size_t)F.gw * 64 + F.lane; i < n; i += T) q[i] = (v4u){0u, 0u, 0u, 0u};
}
constexpr int I_GU = (D / 64) * (FF / 64), I_DN = (FF / 64) * (D / 64), I_IN = (D / 64) * ((NIN + 63) / 64), I_GLU = 16 * 16, I_AB = 16 * 32, I_OUT = 32 * 32;
constexpr int N9 = 224 * 8, N11 = 192 * 8, N2 = 80 * 8, C9 = 2 * I_GU, C11 = C9 + N9, C2 = C11 + N11;
constexpr int P8N = 1472, CV_CARVE = 4 * I_GU - P8N;
constexpr int CV_MAIN = 4 * I_GU + I_DN + I_IN, CV_SMALL = CV_MAIN + I_GLU + 2 * I_AB + I_OUT, CV_END = CV_SMALL + I_DN;
__device__ __forceinline__ void conv_item(Frame& F, const Args& A, int r) {
    LAS float* scr = (LAS float*)(F.lds + F.wave * 16896);
    const int lane = F.lane;
    if (r < I_GU) { const int nnb = FF / 64, kb = r / nnb, nb = r % nnb, n0 = nb * 64; transpose_item(A.in[9], D, FF, WSP(bf16, WS_W1GU), kb, nb, (n0 >> 7) * 256 + (n0 & 127), scr, lane); return; } r -= I_GU;
    if (r < I_GU) { const int nnb = FF / 64, kb = r / nnb, nb = r % nnb, n0 = nb * 64; transpose_item(A.in[10], D, FF, WSP(bf16, WS_W1GU), kb, nb, (n0 >> 7) * 256 + 128 + (n0 & 127), scr, lane); return; } r -= I_GU;
    if (r < I_GU) { const int nnb = FF / 64, kb = r / nnb, nb = r % nnb, n0 = nb * 64; transpose_item(A.in[30], D, FF, WSP(bf16, WS_W2GU), kb, nb, (n0 >> 7) * 256 + (n0 & 127), scr, lane, A.in[29]); return; } r -= I_GU;
    if (r < I_GU) { const int nnb = FF / 64, kb = r / nnb, nb = r % nnb, n0 = nb * 64; transpose_item(A.in[31], D, FF, WSP(bf16, WS_W2GU), kb, nb, (n0 >> 7) * 256 + 128 + (n0 & 127), scr, lane, A.in[29]); return; } r -= I_GU;
    if (r < I_DN) { const int nnb = D / 64, kb = r / nnb, nb = r % nnb; transpose_item(A.in[11], FF, D, WSP(bf16, WS_W1D), kb, nb, nb * 64, scr, lane); return; } r -= I_DN;
    if (r < I_IN) { const int nnb = (NIN + 63) / 64, kb = r / nnb, nb = r % nnb; transpose_item(A.in[13], D, NIN, WSP(bf16, WS_WIN), kb, nb, nb * 64, scr, lane, A.in[12]); return; } r -= I_IN;
    if (r < I_GLU) { const int nnb = 16, kb = r / nnb, nb = r % nnb; transpose_item(A.in[24], 1024, 1024, WSP(bf16, WS_WGLU), kb, nb, nb * 64, scr, lane); return; } r -= I_GLU;
    if (r < I_AB) { const int nnb = 32, kb = r / nnb, nb = r % nnb; transpose_item(A.in[26], 1024, D, WSP(bf16, WS_WA), kb, nb, nb * 64, scr, lane); return; } r -= I_AB;
    if (r < I_AB) { const int nnb = 32, kb = r / nnb, nb = r % nnb; transpose_item(A.in[27], 1024, D, WSP(bf16, WS_WB), kb, nb, nb * 64, scr, lane); return; } r -= I_AB;
    if (r < I_OUT) { const int nnb = 32, kb = r / nnb, nb = r % nnb; transpose_item(A.in[28], D, D, WSP(bf16, WS_WOUT), kb, nb, nb * 64, scr, lane); return; } r -= I_OUT;
    { const int nnb = D / 64, kb = r / nnb, nb = r % nnb; transpose_item(A.in[32], FF, D, WSP(bf16, WS_W2D), kb, nb, nb * 64, scr, lane); }
}
__device__ __forceinline__ void p0_prologue(Frame& F, const Args& A) {
    const int lane = F.lane;
    for (int it = F.gw; it < CV_MAIN - P8N - N9 - N11 - N2; it += F.NGW) { int r = it; if (r >= C9) r += N9 + N11 + N2; if (r >= CV_CARVE) r += P8N; conv_item(F, A, r); }
    for (int m = F.gw; m < MR; m += F.NGW) {
        const float* xr = (m < MP) ? A.in[0] + (size_t)m * D : A.in[1] + (size_t)(m - MP) * D;
        rms_row_to_bf16(xr, A.in[8], WSP(bf16, WS_XN) + (size_t)m * D, nullptr, nullptr, 0, 0.f, lane);
    }
    zero_fill16(F, WSP(bf16, WS_XN) + (size_t)MR * D, (size_t)(MPAD - MR) * D * 2);
    zero_fill16(F, WSP(bf16, WS_WIN) + (size_t)NIN * D, (size_t)(NINP - NIN) * D * 2);
    zero_fill16(F, WSP(bf16, WS_ZA) + (size_t)MR * 1024, (size_t)(MPAD - MR) * 1024 * 2);
    zero_fill16(F, WSP(bf16, WS_BOUT) + (size_t)MR * 1024, (size_t)(MPAD - MR) * 1024 * 2);
    zero_fill16(F, WSP(bf16, WS_MERGED) + (size_t)MR * D, (size_t)(MPAD - MR) * D * 2);
    {
        float* LAMB = (float*)(F.ws + WS_SSMP + SSMP_LAMB); bf16* BT = (bf16*)(F.ws + WS_SSMP + SSMP_BT); bf16* CT = (bf16*)(F.ws + WS_SSMP + SSMP_CT); float* BBF = (float*)(F.ws + WS_SSMP + SSMP_BBF);
        const int T = F.NGW * 64, gt = F.gw * 64 + lane;
        for (int idx = gt; idx < 64 * 64; idx += T) {
            const int g = idx >> 6, p = idx & 63;
            const float lre = A.in[16][idx], lim = A.in[17][idx], dt = expf(A.in[23][g]);
            const float e = expf(lre * dt); float sn, cs; sincos_acc(lim * dt, sn, cs);
            const float lbr = e * cs, lbi = e * sn;
            const float nr = lbr - 1.f, ni = lbi, den = 1.f / (lre * lre + lim * lim);
            const float cr = (nr * lre + ni * lim) * den, ci = (ni * lre - nr * lim) * den;
            LAMB[2 * idx] = lbr; LAMB[2 * idx + 1] = lbi;
#pragma unroll
            for (int c = 0; c < 16; ++c) { const float br = A.in[18][idx * 16 + c], bi = A.in[19][idx * 16 + c];
                const float xr = cr * br - ci * bi, xi = cr * bi + ci * br;
                BT[(g * 128 + p) * 16 + c] = (bf16)f2bf(xr); BT[(g * 128 + 64 + p) * 16 + c] = (bf16)f2bf(xi);
                BBF[(idx * 16 + c) * 2] = xr; BBF[(idx * 16 + c) * 2 + 1] = xi; }
        }
        for (int idx = gt; idx < 64 * 16 * 128; idx += T) {
            const int gc = idx >> 7, comp = idx & 127;
            const float v = (comp & 1) ? -A.in[21][gc * 64 + (comp >> 1)] : A.in[20][gc * 64 + (comp >> 1)];
            CT[idx] = (bf16)f2bf(v);
        }
    }
}
__device__ __forceinline__ void ld16bf(const bf16* p, float (&x)[16]) {
    const v4u a = *(const GAS v4u*)p, b = *(const GAS v4u*)(p + 8);
    x[0] = blo(a.x); x[1] = bhi(a.x); x[2] = blo(a.y); x[3] = bhi(a.y); x[4] = blo(a.z); x[5] = bhi(a.z); x[6] = blo(a.w); x[7] = bhi(a.w);
    x[8] = blo(b.x); x[9] = bhi(b.x); x[10] = blo(b.y); x[11] = bhi(b.y); x[12] = blo(b.z); x[13] = bhi(b.z); x[14] = blo(b.w); x[15] = bhi(b.w);
}
__device__ __forceinline__ void st16bf(bf16* p, const float (&x)[16]) {
    v4u a, b; a.x = pk2(x[0], x[1]); a.y = pk2(x[2], x[3]); a.z = pk2(x[4], x[5]); a.w = pk2(x[6], x[7]); b.x = pk2(x[8], x[9]); b.y = pk2(x[10], x[11]); b.z = pk2(x[12], x[13]); b.w = pk2(x[14], x[15]);
    *(GAS v4u*)p = a; *(GAS v4u*)(p + 8) = b;
}
__device__ __forceinline__ void st16f(float* p, const float (&x)[16]) {
#pragma unroll
    for (int j = 0; j < 4; ++j) *(GAS f32x4*)(p + 4 * j) = (f32x4){x[4 * j], x[4 * j + 1], x[4 * j + 2], x[4 * j + 3]};
}
__device__ __forceinline__ void norm_rope_128(float (&x)[16], const float* gain, int sub, float cs, float sn) {
    float ss = 0.f;
#pragma unroll
    for (int e = 0; e < 16; ++e) ss += x[e] * x[e];
    ss += DPP_F(ss, 0xB1); ss += DPP_F(ss, 0x4E); ss += DPP_F(ss, 0x141);
    const float r = 1.0f / sqrtf(ss * (1.f / 128.f) + EPS);
#pragma unroll
    for (int j = 0; j < 4; ++j) { const f32x4 g = *(const GAS f32x4*)(gain + 16 * sub + 4 * j); x[4 * j] *= r * g.x; x[4 * j + 1] *= r * g.y; x[4 * j + 2] *= r * g.z; x[4 * j + 3] *= r * g.w; }
#pragma unroll
    for (int e = 0; e < 16; ++e) { const float py = DPP_F(x[e], 0xB1), c = LANE_F(cs, e), s = LANE_F(sn, e);
        const float a = x[e] * c - py * s, b = x[e] * c + py * s; x[e] = (sub == 0) ? a : ((sub == 1) ? b : x[e]); }
}
__device__ __forceinline__ void post_row(Frame& F, const Args& A, int row) {
    const int lane = F.lane;
    const bf16* zr = WSP(bf16, WS_Z) + (size_t)row * NINP;
    const bool isp = row < MP;
    const int pos = isp ? (row & (SEQ - 1)) : (PAST + ((row - MP) & 3));
    float cs, sn; sincos_acc((float)pos * ROPE_FQ[lane < 24 ? lane : 0], sn, cs);
    float x[16];
    ld16bf(zr + ZQ + 16 * lane, x); norm_rope_128(x, A.in[14], lane & 7, cs, sn);
#pragma unroll
    for (int e = 0; e < 16; ++e) x[e] *= QSCALE;
    st16bf(WSP(bf16, WS_QB) + (size_t)row * 1024 + 16 * lane, x);
    { const int kl = lane & 15; ld16bf(zr + ZK + 16 * kl, x); norm_rope_128(x, A.in[15], kl & 7, cs, sn);
      float* ko = isp ? F.out + O_KP + (size_t)row * 256 : F.out + O_KS + (size_t)(row - MP) * 256;
      if (lane < 16) { st16f(ko + 16 * kl, x); if (isp) st16bf(WSP(bf16, WS_KB) + ((size_t)(((row >> 11) * 2 + (kl >> 3)) * SEQ + (row & (SEQ - 1)))) * 128 + 16 * (kl & 7), x); } }
    { const int kl = lane & 15; ld16bf(zr + ZV + 16 * kl, x);
      float* vo = isp ? F.out + O_VP + (size_t)row * 256 : F.out + O_VS + (size_t)(row - MP) * 256;
      if (lane < 16) st16f(vo + 16 * kl, x); }
    { ld16bf(zr + ZQI + 16 * lane, x); const bool rot = (lane & 3) == 0;
#pragma unroll
      for (int e = 0; e < 8; ++e) { const float c = LANE_F(cs, 16 + e), s = LANE_F(sn, 16 + e); const float a = x[e] * c - x[e + 8] * s, b = x[e + 8] * c + x[e] * s; if (rot) { x[e] = a; x[e + 8] = b; } }
      st16bf(WSP(bf16, WS_QIB) + (size_t)row * 1024 + 16 * lane, x); }
    { const int kl = lane & 3; ld16bf(zr + ZKI + 16 * kl, x); const bool rot = kl == 0;
#pragma unroll
      for (int e = 0; e < 8; ++e) { const float c = LANE_F(cs, 16 + e), s = LANE_F(sn, 16 + e); const float a = x[e] * c - x[e + 8] * s, b = x[e + 8] * c + x[e] * s; if (rot) { x[e] = a; x[e + 8] = b; } }
      float* io = isp ? F.out + O_IKP + (size_t)row * 64 : F.out + O_IKS + (size_t)(row - MP) * 64;
      if (lane < 4) { st16f(io + 16 * kl, x);
          if (!isp) st16bf(WSP(bf16, WS_KIB) + (size_t)row * 64 + 16 * kl, x);
          else {
              bf16* fp = WSP(bf16, WS_KIB) + ((size_t)(row >> 5) * 4 + kl) * 512 + (row & 31) * 8;
              v4u a, b2; a.x = pk2(x[0], x[1]); a.y = pk2(x[2], x[3]); a.z = pk2(x[4], x[5]); a.w = pk2(x[6], x[7]); b2.x = pk2(x[8], x[9]); b2.y = pk2(x[10], x[11]); b2.z = pk2(x[12], x[13]); b2.w = pk2(x[14], x[15]);
              *(GAS v4u*)fp = a; *(GAS v4u*)(fp + 256) = b2; } } }
    if (lane < 16) WSP(float, WS_WIF)[(size_t)row * 16 + lane] = bf2f(zr[ZWI + lane]) * (0.25f * 0.125f);
}
__device__ __forceinline__ int swap23(int x) { return (x & ~12) | ((x & 4) << 1) | ((x & 8) >> 1); }
__device__ __forceinline__ void vt_item(Frame& F, int item) {
    const int b = item >> 6, g = (item >> 5) & 1, kb = item & 31, tid = F.tid;
    LAS bf16* tile = (LAS bf16*)F.lds;
    const bf16* Z = WSP(bf16, WS_Z);
#pragma unroll
    for (int i = 0; i < 2; ++i) { const int ch = tid + 512 * i, key = ch >> 4, c8 = ch & 15;
        const v4u v = *(const GAS v4u*)(Z + (size_t)(b * SEQ + kb * 64 + key) * NINP + ZV + g * 128 + c8 * 8);
        *(LAS v4u*)(tile + key * 136 + c8 * 8) = v; }
    __syncthreads();
    { const int d = tid & 127, qu = tid >> 7; unsigned w[8];
#pragma unroll
      for (int pp = 0; pp < 8; ++pp) { const unsigned lo = tile[(16 * qu + swap23(2 * pp)) * 136 + d], hi = tile[(16 * qu + swap23(2 * pp + 1)) * 136 + d]; w[pp] = lo | (hi << 16); }
      bf16* dst = WSP(bf16, WS_VT) + ((size_t)(((b * 2 + g) * 64 + kb * 2 + (qu >> 1)) * 128 + d)) * 32 + 16 * (qu & 1);
      *(GAS v4u*)dst = (v4u){w[0], w[1], w[2], w[3]}; *(GAS v4u*)(dst + 8) = (v4u){w[4], w[5], w[6], w[7]}; }
    __syncthreads();
}
__device__ __forceinline__ void p5_post(Frame& F, const Args& A) {
    for (int m = F.gw; m < MR; m += F.NGW) post_row(F, A, m);
    for (int it = F.vcu; it < 256; it += F.G) vt_item(F, it);
}
__device__ __forceinline__ void ssm_tile_bu(const v4u uraw, const bf16x8 (&bfr)[4], LAS unsigned char* W, LAS bf16* Ut, bool keep_u, int lane) {
    const int r = lane & 31, hh = lane >> 5;
    if (keep_u) *(LAS v4u*)(Ut + r * 16 + 8 * hh) = uraw;
    const bf16x8 af = __builtin_bit_cast(bf16x8, uraw);
    f32x16 acc[4];
#pragma unroll
    for (int ct = 0; ct < 4; ++ct) { acc[ct] = (f32x16){}; acc[ct] = MFMA32(af, bfr[ct], acc[ct]); }
#pragma unroll
    for (int j = 0; j < 16; ++j) { const int tok = (j & 3) + 8 * (j >> 2) + 4 * hh;
        *(LAS unsigned*)(W + tok * SSM_WPITCH + r * 4) = pk2(acc[0][j], acc[2][j]); *(LAS unsigned*)(W + tok * SSM_WPITCH + (32 + r) * 4) = pk2(acc[1][j], acc[3][j]); }
}
__device__ __forceinline__ void ssm_prompt_item(Frame& F, const Args& A, int b, int g) {
    const int lane = F.lane, wave = F.wave;
    const bf16* Z = WSP(bf16, WS_Z);
    const float* LAMB = (const float*)(F.ws + WS_SSMP + SSMP_LAMB); const bf16* BT = (const bf16*)(F.ws + WS_SSMP + SSMP_BT); const bf16* CT = (const bf16*)(F.ws + WS_SSMP + SSMP_CT);
    LAS unsigned char* W = F.lds + wave * SSM_WBYTES; LAS bf16* Ut = (LAS bf16*)(F.lds + SSM_UOFF + wave * 1024); LAS float* E = (LAS float*)(F.lds + SSM_EOFF);
    const int r = lane & 31, hh = lane >> 5, rowb = b * SEQ + wave * 256;
    bf16x8 bfr[4];
#pragma unroll
    for (int ct = 0; ct < 4; ++ct) bfr[ct] = *(const GAS bf16x8*)(BT + (size_t)((g * 128 + ct * 32 + r) * 16 + 8 * hh));
    const float lr = LAMB[(g * 64 + lane) * 2], li = LAMB[(g * 64 + lane) * 2 + 1];
    float hr = 0.f, hi = 0.f;
    const bf16* up = Z + (size_t)(rowb + r) * NINP + ZU + g * 16 + 8 * hh;
    v4u ucur = *(const GAS v4u*)up;
    for (int tt = 0; tt < 8; ++tt) {
        const v4u unow = ucur; ucur = *(const GAS v4u*)(up + (size_t)((tt < 7 ? tt + 1 : 7) * 32) * NINP);
        ssm_tile_bu(unow, bfr, W, Ut, false, lane);
        LDS_WAIT(); asm volatile("" ::: "memory");
#pragma unroll 8
        for (int t = 0; t < 32; ++t) { const unsigned bu = *(LAS unsigned*)(W + t * SSM_WPITCH + lane * 4);
            const float nr = lr * hr - li * hi + blo(bu), ni = lr * hi + li * hr + bhi(bu); hr = nr; hi = ni; }
        asm volatile("" ::: "memory");
    }
    E[(wave * 64 + lane) * 2] = hr; E[(wave * 64 + lane) * 2 + 1] = hi;
    __syncthreads();
    if (wave == 0) {
        float pr = lr, pi = li;
#pragma unroll
        for (int k = 0; k < 8; ++k) { const float a = pr * pr - pi * pi, c = 2.f * pr * pi; pr = a; pi = c; }
        float cr = 0.f, ci = 0.f;
#pragma unroll
        for (int c = 0; c < 8; ++c) { const float er = E[(c * 64 + lane) * 2], ei = E[(c * 64 + lane) * 2 + 1];
            E[(c * 64 + lane) * 2] = cr; E[(c * 64 + lane) * 2 + 1] = ci;
            const float nr = pr * cr - pi * ci + er, ni = pr * ci + pi * cr + ei; cr = nr; ci = ni; }
        F.out[O_SRP + (size_t)(b * 64 + g) * 64 + lane] = cr; F.out[O_SIP + (size_t)(b * 64 + g) * 64 + lane] = ci;
    }
    __syncthreads();
    hr = E[(wave * 64 + lane) * 2]; hi = E[(wave * 64 + lane) * 2 + 1];
    bf16x8 cfr[8];
#pragma unroll
    for (int ks = 0; ks < 8; ++ks) { cfr[ks] = (bf16x8){0, 0, 0, 0, 0, 0, 0, 0}; if (r < 16) cfr[ks] = *(const GAS bf16x8*)(CT + (size_t)((g * 16 + r) * 128 + 16 * ks + 8 * hh)); }
    const float dv = (r < 16) ? A.in[22][g * 16 + r] : 0.f;
    bf16* ZA = WSP(bf16, WS_ZA);
    ucur = *(const GAS v4u*)up;
    for (int tt = 0; tt < 8; ++tt) {
        const v4u unow = ucur; ucur = *(const GAS v4u*)(up + (size_t)((tt < 7 ? tt + 1 : 7) * 32) * NINP);
        ssm_tile_bu(unow, bfr, W, Ut, true, lane);
        LDS_WAIT(); asm volatile("" ::: "memory");
#pragma unroll 8
        for (int t = 0; t < 32; ++t) { const unsigned bu = *(LAS unsigned*)(W + t * SSM_WPITCH + lane * 4);
            const float nr = lr * hr - li * hi + blo(bu), ni = lr * hi + li * hr + bhi(bu); hr = nr; hi = ni;
            *(LAS unsigned*)(W + t * SSM_WPITCH + lane * 4) = pk2(hr, hi); }
        LDS_WAIT(); asm volatile("" ::: "memory");
        f32x16 y = {};
#pragma unroll
        for (int ks = 0; ks < 8; ++ks) { const bf16x8 hf = *(LAS bf16x8*)(W + r * SSM_WPITCH + (16 * ks + 8 * hh) * 2); y = MFMA32(hf, cfr[ks], y); }
        if (r < 16) {
#pragma unroll
            for (int j = 0; j < 16; ++j) { const int tok = (j & 3) + 8 * (j >> 2) + 4 * hh; const float uv = bf2f(Ut[tok * 16 + r]);
                Ut[tok * 16 + r] = (bf16)f2bf(gelu_tanh(y[j] + dv * uv)); }
        }
        LDS_WAIT(); asm volatile("" ::: "memory");
        { const v4u yv = *(LAS v4u*)(Ut + (lane >> 1) * 16 + (lane & 1) * 8);
          *(GAS v4u*)(ZA + (size_t)(rowb + 32 * tt + (lane >> 1)) * 1024 + g * 16 + (lane & 1) * 8) = yv; }
        LDS_WAIT(); asm volatile("" ::: "memory");
    }
    __syncthreads();
}
__device__ __forceinline__ void ssm_sample_item(Frame& F, const Args& A, int item) {
    const int lane = F.lane, db = item >> 6, g = item & 63;
    const float* LAMB = (const float*)(F.ws + WS_SSMP + SSMP_LAMB); const float* BBF = (const float*)(F.ws + WS_SSMP + SSMP_BBF);
    const float lr = LAMB[(g * 64 + lane) * 2], li = LAMB[(g * 64 + lane) * 2 + 1];
    float hr = A.in[5][(size_t)(db * 64 + g) * 64 + lane], hi = A.in[6][(size_t)(db * 64 + g) * 64 + lane];
    f32x4 bb[8];
#pragma unroll
    for (int j = 0; j < 8; ++j) bb[j] = *(const GAS f32x4*)(BBF + (size_t)((g * 64 + lane) * 16) * 2 + 4 * j);
    const bool up0 = (lane ^ (lane >> 2)) & 1, up1 = ((lane >> 1) ^ (lane >> 2)) & 1, up2 = (lane >> 2) & 1, up3 = (lane >> 3) & 1;
    const int chl = (up3 ? 8 : 0) | (up2 ? 4 : 0) | (up1 ? 2 : 0) | (up0 ? 1 : 0);
    const float dv = (lane < 16) ? A.in[22][g * 16 + chl] : 0.f;
    for (int j = 0; j < DSEQ; ++j) {
        const int row = MP + db * DSEQ + j;
        float u[16]; ld16bf(WSP(bf16, WS_Z) + (size_t)row * NINP + ZU + g * 16, u);
        float br = 0.f, bi = 0.f;
#pragma unroll
        for (int c = 0; c < 8; ++c) { br += bb[c].x * u[2 * c] + bb[c].z * u[2 * c + 1]; bi += bb[c].y * u[2 * c] + bb[c].w * u[2 * c + 1]; }
        const float nr = lr * hr - li * hi + br, ni = lr * hi + li * hr + bi; hr = nr; hi = ni;
        float v[16];
#pragma unroll
        for (int ch = 0; ch < 16; ++ch) { const float cre = A.in[20][(size_t)(g * 16 + ch) * 64 + lane], cim = A.in[21][(size_t)(g * 16 + ch) * 64 + lane]; v[ch] = cre * hr - cim * hi; }
#pragma unroll
        for (int e = 0; e < 8; ++e) { const float keep = up0 ? v[2 * e + 1] : v[2 * e], send = up0 ? v[2 * e] : v[2 * e + 1]; v[e] = keep + DPP_F(send, 0xB1); }
#pragma unroll
        for (int e = 0; e < 4; ++e) { const float keep = up1 ? v[2 * e + 1] : v[2 * e], send = up1 ? v[2 * e] : v[2 * e + 1]; v[e] = keep + DPP_F(send, 0x4E); }
#pragma unroll
        for (int e = 0; e < 2; ++e) { const float keep = up2 ? v[2 * e + 1] : v[2 * e], send = up2 ? v[2 * e] : v[2 * e + 1]; v[e] = keep + DPP_F(send, 0x141); }
        { const float keep = up3 ? v[1] : v[0], send = up3 ? v[0] : v[1]; v[0] = keep + DPP_F(send, 0x128); }
        float ymine = v[0];
        { auto r1 = __builtin_amdgcn_permlane16_swap(__float_as_uint(ymine), __float_as_uint(ymine), false, false); ymine = __uint_as_float(r1[0]) + __uint_as_float(r1[1]); }
        ymine = swap32_sum(ymine);
        float umine = 0.f;
#pragma unroll
        for (int ch = 0; ch < 16; ++ch) umine = (chl == ch) ? u[ch] : umine;
        if (lane < 16) WSP(bf16, WS_ZA)[(size_t)row * 1024 + g * 16 + chl] = (bf16)f2bf(gelu_tanh(ymine + dv * umine));
    }
    F.out[O_SRS + (size_t)(db * 64 + g) * 64 + lane] = hr; F.out[O_SIS + (size_t)(db * 64 + g) * 64 + lane] = hi;
}
__device__ __forceinline__ int idx_prompt_score(Frame& F, int b, int t0) {
    const int lane = F.lane, r = lane & 31, hh = lane >> 5;
    const int qa = (r >> 2) & 1, ha = (r & 3) + 4 * (r >> 3);
    const bf16* qrow = WSP(bf16, WS_QIB) + (size_t)(b * SEQ + t0 + qa) * 1024 + ha * 64 + 8 * hh;
    bf16x8 af[4];
#pragma unroll
    for (int ks = 0; ks < 4; ++ks) af[ks] = *(const GAS bf16x8*)(qrow + 16 * ks);
    float w[16];
    { const float* wp = WSP(float, WS_WIF) + (size_t)(b * SEQ + t0 + hh) * 16;
#pragma unroll
      for (int j = 0; j < 4; ++j) { const f32x4 v = *(const GAS f32x4*)(wp + 4 * j); w[4 * j] = v.x; w[4 * j + 1] = v.y; w[4 * j + 2] = v.z; w[4 * j + 3] = v.w; } }
    const int t = t0 + hh, nkt = ((t0 + 1) >> 5) + 1;
    const bf16* kbase = WSP(bf16, WS_KIB) + (size_t)b * SEQ * 64 + (hh * 32 + r) * 8;
    LAS float* ksc = (LAS float*)(F.lds + F.wave * 16384);
    const float qnan = __builtin_nanf("");
    const int nkt4 = (nkt + 3) & ~3;
    bf16x8 ba[4][4], bb[4][4];
#define IX_LOAD(S, KT0) do { _Pragma("unroll") for (int u = 0; u < 4; ++u) _Pragma("unroll") for (int ks = 0; ks < 4; ++ks) S[u][ks] = *(const GAS bf16x8*)(kbase + (size_t)(((KT0) + u) * 4 + ks) * 512); } while (0)
#define IX_COMP(S, KT0) do { _Pragma("unroll") for (int u = 0; u < 4; ++u) { const int kt = (KT0) + u; f32x16 acc = {}; \
            _Pragma("unroll") for (int ks = 0; ks < 4; ++ks) acc = MFMA32(af[ks], S[u][ks], acc); \
            float s = 0.f; \
            _Pragma("unroll") for (int j = 0; j < 16; ++j) s = fmaf(w[j], __builtin_amdgcn_fmed3f(acc[j], 0.f, __builtin_inff()), s); \
            ksc[kt * 64 + lane] = (kt * 32 + r <= t) ? s : qnan; } \
        asm volatile("" ::: "memory"); __builtin_amdgcn_sched_barrier(0); } while (0)
    IX_LOAD(ba, 0);
    for (int kt0 = 0; kt0 < nkt4; kt0 += 8) {
        const bool hasb = kt0 + 4 < nkt4;
        if (hasb) { IX_LOAD(bb, kt0 + 4); asm volatile("s_waitcnt vmcnt(16)" ::: "memory"); } else asm volatile("s_waitcnt vmcnt(0)" ::: "memory");
        __builtin_amdgcn_sched_barrier(0);
        IX_COMP(ba, kt0);
        if (hasb) {
            if (kt0 + 8 < nkt4) { IX_LOAD(ba, kt0 + 8); asm volatile("s_waitcnt vmcnt(16)" ::: "memory"); } else asm volatile("s_waitcnt vmcnt(0)" ::: "memory");
            __builtin_amdgcn_sched_barrier(0);
            IX_COMP(bb, kt0 + 4);
        }
    }
#undef IX_COMP
#undef IX_LOAD
    return nkt4;
}
template <int NK> __device__ __forceinline__ void idx_prompt_select(Frame& F, int b, int t0, int nkt4) {
    const int lane = F.lane, hh = lane >> 5; const int t = t0 + hh;
    LAS float* ksc = (LAS float*)(F.lds + F.wave * 16384);
    const float qnan = __builtin_nanf("");
    for (int kt = nkt4; kt < NK; ++kt) ksc[kt * 64 + lane] = qnan;
    LDS_WAIT(); asm volatile("" ::: "memory");
    float sc[NK];
#pragma unroll
    for (int kt = 0; kt < NK; ++kt) sc[kt] = ksc[kt * 64 + lane];
    LDS_WAIT(); asm volatile("" ::: "memory");
    float thr = -__builtin_inff();
    bool done = (t + 1 <= 256);
    if (!__all(done)) {
        float lo = sc[0], hi = sc[0];
#pragma unroll
        for (int kt = 1; kt < NK; ++kt) { lo = fminf(lo, sc[kt]); hi = fmaxf(hi, sc[kt]); }
        lo = half_min_f(lo); hi = half_max_f(hi);
        if (!done) thr = lo;
        for (int it = 0; it < 48; ++it) {
            const float mid = 0.5f * lo + 0.5f * hi;
            int cnt = 0;
#pragma unroll
            for (int kt = 0; kt < NK; ++kt) cnt += (sc[kt] >= mid) ? 1 : 0;
            cnt = half_sum_i(cnt);
            if (!done) {
                if (!(mid > lo && mid < hi)) done = true;
                else if (cnt == 256) { thr = mid; done = true; }
                else if (cnt > 256) { lo = mid; thr = mid; }
                else hi = mid;
            }
            if (__all(done)) break;
        }
    }
    unsigned w0 = 0u, w1 = 0u;
#pragma unroll
    for (int kt = 0; kt < NK; ++kt) { const unsigned long long bm = __ballot(sc[kt] >= thr); if (lane == kt) { w0 = (unsigned)bm; w1 = (unsigned)(bm >> 32); } }
    unsigned* mk = WSP(unsigned, WS_MASK) + (size_t)(b * SEQ + t0) * 64;
    mk[lane] = w0; mk[64 + lane] = w1;
}
__device__ __forceinline__ void idx_sample_item(Frame& F, const Args& A, int item) {
    const int lane = F.lane, r = lane & 31, hh = lane >> 5, db = item >> 6, pg = item & 63;
    const int qa = (r >> 2) & 1, ha = (r & 3) + 4 * (r >> 3), base = MP + db * DSEQ;
    bf16x8 af[2][4]; float w[2][16];
#pragma unroll
    for (int rt = 0; rt < 2; ++rt) {
        const bf16* qrow = WSP(bf16, WS_QIB) + (size_t)(base + 2 * rt + qa) * 1024 + ha * 64 + 8 * hh;
#pragma unroll
        for (int ks = 0; ks < 4; ++ks) af[rt][ks] = *(const GAS bf16x8*)(qrow + 16 * ks);
        const float* wp = WSP(float, WS_WIF) + (size_t)(base + 2 * rt + hh) * 16;
#pragma unroll
        for (int j = 0; j < 4; ++j) { const f32x4 v = *(const GAS f32x4*)(wp + 4 * j); w[rt][4 * j] = v.x; w[rt][4 * j + 1] = v.y; w[rt][4 * j + 2] = v.z; w[rt][4 * j + 3] = v.w; }
    }
    float* ssc = WSP(float, WS_SSC);
    {
        const int phys = ((const int*)A.in[7])[db * NPAGES + pg];
        f32x4 kx[4][8];
#pragma unroll
        for (int k4 = 0; k4 < 4; ++k4) { const float* kr = A.in[4] + ((size_t)phys * 128 + 32 * k4 + r) * 64 + 8 * hh;
#pragma unroll
            for (int ks = 0; ks < 4; ++ks) { kx[k4][2 * ks] = *(const GAS f32x4*)(kr + 16 * ks); kx[k4][2 * ks + 1] = *(const GAS f32x4*)(kr + 16 * ks + 4); } }
        asm volatile("s_waitcnt vmcnt(0)" ::: "memory"); __builtin_amdgcn_sched_barrier(0);
#pragma unroll
        for (int k4 = 0; k4 < 4; ++k4) {
            f32x16 acc0 = {}, acc1 = {};
#pragma unroll
            for (int ks = 0; ks < 4; ++ks) { const f32x4 a = kx[k4][2 * ks], c = kx[k4][2 * ks + 1];
                v4u pk; pk.x = pk2(a.x, a.y); pk.y = pk2(a.z, a.w); pk.z = pk2(c.x, c.y); pk.w = pk2(c.z, c.w); const bf16x8 bk = __builtin_bit_cast(bf16x8, pk);
                acc0 = MFMA32(af[0][ks], bk, acc0); acc1 = MFMA32(af[1][ks], bk, acc1); }
            float s0 = 0.f, s1 = 0.f;
#pragma unroll
            for (int j = 0; j < 16; ++j) { s0 = fmaf(w[0][j], __builtin_amdgcn_fmed3f(acc0[j], 0.f, __builtin_inff()), s0); s1 = fmaf(w[1][j], __builtin_amdgcn_fmed3f(acc1[j], 0.f, __builtin_inff()), s1); }
            const int kidx = pg * 128 + 32 * k4 + r;
            ssc[(size_t)(db * DSEQ + hh) * SSCLD + kidx] = s0; ssc[(size_t)(db * DSEQ + 2 + hh) * SSCLD + kidx] = s1;
        }
    }
    if (pg == NPAGES - 1) {
        const bf16* kr = WSP(bf16, WS_KIB) + (size_t)(base + (r & 3)) * 64 + 8 * hh;
        f32x16 acc0 = {}, acc1 = {};
#pragma unroll
        for (int ks = 0; ks < 4; ++ks) { const bf16x8 bk = *(const GAS bf16x8*)(kr + 16 * ks); acc0 = MFMA32(af[0][ks], bk, acc0); acc1 = MFMA32(af[1][ks], bk, acc1); }
        float s0 = 0.f, s1 = 0.f;
#pragma unroll
        for (int j = 0; j < 16; ++j) { s0 = fmaf(w[0][j], __builtin_amdgcn_fmed3f(acc0[j], 0.f, __builtin_inff()), s0); s1 = fmaf(w[1][j], __builtin_amdgcn_fmed3f(acc1[j], 0.f, __builtin_inff()), s1); }
        if (r < DSEQ) { const float ninf = -__builtin_inff();
            ssc[(size_t)(db * DSEQ + hh) * SSCLD + PAST + r] = (r <= hh) ? s0 : ninf; ssc[(size_t)(db * DSEQ + 2 + hh) * SSCLD + PAST + r] = (r <= 2 + hh) ? s1 : ninf; }
    }
}
#ifndef P6_REP
#define P6_REP 0
#endif
__device__ __forceinline__ void p6_mix_a(Frame& F, const Args& A) {
    for (int rr = 0; rr <= ((P6_REP >> 0) & 1); ++rr)
    for (int it = F.vcu; it < 256; it += F.G) ssm_prompt_item(F, A, it >> 6, it & 63);
    for (int rr = 0; rr <= ((P6_REP >> 1) & 1); ++rr)
    for (int it = F.gw; it < DBATCH * 64; it += F.NGW) ssm_sample_item(F, A, it);
    for (int rr = 0; rr <= ((P6_REP >> 2) & 1); ++rr)
    for (int it = F.gw; it < 2048; it += F.NGW) {
        const int b = it >> 9, i = it & 511;
        for (int rep = 0; rep < 2; ++rep) { const int t0 = rep ? 2 * (1023 - i) : 2 * i; const int n4 = idx_prompt_score(F, b, t0);
            switch ((n4 + 7) >> 3) { case 1: idx_prompt_select<8>(F, b, t0, n4); break; case 2: idx_prompt_select<16>(F, b, t0, n4); break; case 3: idx_prompt_select<24>(F, b, t0, n4); break; case 4: idx_prompt_select<32>(F, b, t0, n4); break;
                case 5: idx_prompt_select<40>(F, b, t0, n4); break; case 6: idx_prompt_select<48>(F, b, t0, n4); break; case 7: idx_prompt_select<56>(F, b, t0, n4); break; default: idx_prompt_select<64>(F, b, t0, n4); break; } }
    }
    for (int rr = 0; rr <= ((P6_REP >> 3) & 1); ++rr)
    for (int it = F.gw; it < DBATCH * 64; it += F.NGW) idx_sample_item(F, A, it);
}
constexpr int AT_KP = 272, AT_VP = 80, AT_KB = 32 * AT_KP, AT_VB = 128 * AT_VP, AT_BUF = AT_KB + AT_VB, AT_GRP = 2 * AT_BUF, AT_X = 2 * AT_GRP;
__device__ __forceinline__ void attn_tile(LAS unsigned char* kb, const bf16x8 (&kf)[4], const bf16x8 (&qf)[8], f32x16 (&o)[4], float& m, float& l, unsigned mwc, int cq, int hh) {
    const unsigned mw = mwc >> (4 * hh);
    f32x16 s;
#pragma unroll
    for (int j = 0; j < 16; ++j) s[j] = ((mw >> ((j & 3) + 8 * (j >> 2))) & 1u) ? 0.f : -1e30f;
#pragma unroll
    for (int ks = 0; ks < 4; ++ks) s = MFMA32(kf[ks], qf[ks], s);
#pragma unroll
    for (int ks = 4; ks < 8; ++ks) { const bf16x8 kl = *(const LAS bf16x8*)(kb + cq * AT_KP + (16 * ks + 8 * hh) * 2); s = MFMA32(kl, qf[ks], s); }
    bf16x8 vf[4];
#pragma unroll
    for (int dt = 0; dt < 2; ++dt)
#pragma unroll
        for (int s2 = 0; s2 < 2; ++s2) vf[2 * dt + s2] = *(const LAS bf16x8*)(kb + AT_KB + (dt * 32 + cq) * AT_VP + (16 * s2 + 8 * hh) * 2);
    __builtin_amdgcn_sched_barrier(0);
    float mx = -1e30f;
#pragma unroll
    for (int j = 0; j < 16; ++j) mx = fmaxf(mx, s[j]);
    mx = swap32_max(mx);
    const float mn = fmaxf(m, mx), alpha = __builtin_amdgcn_exp2f(m - mn); m = mn;
    float ps = 0.f;
#pragma unroll
    for (int j = 0; j < 16; ++j) { const float p = __builtin_amdgcn_exp2f(s[j] - mn); s[j] = p; ps += p; }
    l = l * alpha + ps;
    if (!__all(alpha == 1.0f)) {
#pragma unroll
        for (int dt = 0; dt < 4; ++dt) o[dt] = o[dt] * alpha; }
    bf16x8 pf[2];
#pragma unroll
    for (int s2 = 0; s2 < 2; ++s2) { v4u pk; pk.x = pk2(s[8 * s2], s[8 * s2 + 1]); pk.y = pk2(s[8 * s2 + 2], s[8 * s2 + 3]); pk.z = pk2(s[8 * s2 + 4], s[8 * s2 + 5]); pk.w = pk2(s[8 * s2 + 6], s[8 * s2 + 7]); pf[s2] = __builtin_bit_cast(bf16x8, pk); }
#pragma unroll
    for (int dt = 0; dt < 4; ++dt)
#pragma unroll
        for (int s2 = 0; s2 < 2; ++s2) { if (dt < 2) o[dt] = MFMA32(vf[2 * dt + s2], pf[s2], o[dt]);
            else { const bf16x8 vl = *(const LAS bf16x8*)(kb + AT_KB + (dt * 32 + cq) * AT_VP + (16 * s2 + 8 * hh) * 2); o[dt] = MFMA32(vl, pf[s2], o[dt]); } }
}
__device__ __forceinline__ void attn_block(Frame& F, int b, int g, int i) {
    const int lane = F.lane, wave = F.wave, cq = lane & 31, hh = lane >> 5, hq = wave & 3, kh = wave >> 2, head = 4 * g + hq;
    const int q256 = hq * 64 + lane;
    const int qrow = b * SEQ + 32 * i + cq;
    bf16x8 qf[8];
    { const bf16* qp = WSP(bf16, WS_QB) + (size_t)qrow * 1024 + head * 128 + 8 * hh;
#pragma unroll
      for (int ks = 0; ks < 8; ++ks) qf[ks] = *(const GAS bf16x8*)(qp + 16 * ks); }
    f32x16 o[4] = {{}, {}, {}, {}}; float m = -1e30f, l = 0.f;
    const bf16* ksrc = WSP(bf16, WS_KB) + (size_t)(b * 2 + g) * SEQ * 128;
    const bf16* vsrc = WSP(bf16, WS_VT) + (size_t)(b * 2 + g) * 64 * 4096;
    const unsigned* mp = WSP(unsigned, WS_MASK) + (size_t)qrow * 64;
    LAS unsigned char* gb = F.lds + kh * AT_GRP;
    const int kw0 = (q256 >> 4) * AT_KP + (q256 & 15) * 16, kw1 = ((q256 + 256) >> 4) * AT_KP + (q256 & 15) * 16;
    const int vw0 = (q256 >> 2) * AT_VP + (q256 & 3) * 16, vw1 = ((q256 + 256) >> 2) * AT_VP + (q256 & 3) * 16;
    const int nsteps = (i + 2) >> 1;
#define AT_LOAD(K0, K1, V0, V1, MW, T) do { K0 = *(const GAS v4u*)(ksrc + (size_t)(T) * 4096 + q256 * 8); K1 = *(const GAS v4u*)(ksrc + (size_t)(T) * 4096 + (q256 + 256) * 8); \
        V0 = *(const GAS v4u*)(vsrc + (size_t)(T) * 4096 + q256 * 8); V1 = *(const GAS v4u*)(vsrc + (size_t)(T) * 4096 + (q256 + 256) * 8); MW = mp[T]; } while (0)
#define AT_STORE(BUF, K0, K1, V0, V1) do { *(LAS v4u*)((BUF) + kw0) = K0; *(LAS v4u*)((BUF) + kw1) = K1; *(LAS v4u*)((BUF) + AT_KB + vw0) = V0; *(LAS v4u*)((BUF) + AT_KB + vw1) = V1; } while (0)
    v4u ak0 = {0u, 0u, 0u, 0u}, ak1 = ak0, av0 = ak0, av1 = ak0, bk0 = ak0, bk1 = ak0, bv0 = ak0, bv1 = ak0; unsigned amw = 0u, bmw = 0u, mwc = 0u, mwp = 0u;
    if (kh <= i) { v4u k0, k1, v0, v1; AT_LOAD(k0, k1, v0, v1, mwp, kh); AT_STORE(gb, k0, k1, v0, v1); }
    if (kh + 2 <= i) AT_LOAD(bk0, bk1, bv0, bv1, bmw, kh + 2);
    if (kh + 4 <= i) AT_LOAD(ak0, ak1, av0, av1, amw, kh + 4);
#define AT_STEP(ST, K0, K1, V0, V1, MW) do { \
        __syncthreads(); \
        const int kt = 2 * (ST) + kh; \
        LAS unsigned char* kb = gb + ((ST) & 1) * AT_BUF; LAS unsigned char* nb = gb + (((ST) + 1) & 1) * AT_BUF; \
        mwc = mwp; \
        bf16x8 kf[4];                                                  \
        _Pragma("unroll") for (int ks = 0; ks < 4; ++ks) kf[ks] = *(const LAS bf16x8*)(kb + cq * AT_KP + (16 * ks + 8 * hh) * 2); \
        __builtin_amdgcn_sched_barrier(0); \
        if (kt + 2 <= i) { AT_STORE(nb, K0, K1, V0, V1); mwp = MW; } \
        if (kt + 6 <= i) AT_LOAD(K0, K1, V0, V1, MW, kt + 6); \
        if (kt <= i) attn_tile(kb, kf, qf, o, m, l, mwc, cq, hh); \
    } while (0)
    for (int st = 0; st < nsteps; st += 2) {
        AT_STEP(st, bk0, bk1, bv0, bv1, bmw);
        if (st + 1 < nsteps) AT_STEP(st + 1, ak0, ak1, av0, av1, amw);
    }
#undef AT_STEP
#undef AT_STORE
#undef AT_LOAD
    if (m < -1e29f) { l = 0.f;
#pragma unroll
        for (int dt = 0; dt < 4; ++dt) o[dt] = o[dt] * 0.f; }
    LAS float* X = (LAS float*)(F.lds + AT_X) + (size_t)(hq * 64 + lane) * 67;
    if (kh == 1) { X[0] = m; X[1] = l;
#pragma unroll
        for (int dt = 0; dt < 4; ++dt)
#pragma unroll
            for (int j = 0; j < 16; ++j) X[2 + dt * 16 + j] = o[dt][j]; }
    __syncthreads();
    if (kh == 0) {
        const float m1 = X[0], l1 = X[1], mt = fmaxf(m, m1), a0 = __builtin_amdgcn_exp2f(m - mt), a1 = __builtin_amdgcn_exp2f(m1 - mt);
        const float lt = swap32_sum(l * a0 + l1 * a1), inv = 1.0f / lt;
        bf16* op = WSP(bf16, WS_BOUT) + (size_t)qrow * 1024 + head * 128;
#pragma unroll
        for (int dt = 0; dt < 4; ++dt)
#pragma unroll
            for (int jq = 0; jq < 4; ++jq) { float v[4];
#pragma unroll
                for (int e = 0; e < 4; ++e) v[e] = (o[dt][4 * jq + e] * a0 + X[2 + dt * 16 + 4 * jq + e] * a1) * inv;
                v2u wv; wv.x = pk2(v[0], v[1]); wv.y = pk2(v[2], v[3]); *(GAS v2u*)(op + 32 * dt + 8 * jq + 4 * hh) = wv; }
    }
    __syncthreads();
}
__device__ __forceinline__ void attn_sample_item(Frame& F, const Args& A, int item) {
    const int tid = F.tid, lane = F.lane, wave = F.wave, qi = item >> 1, grp = item & 1, db = qi >> 2;
    LAS int* red = (LAS int*)F.lds;
    LAS int* cntw = (LAS int*)(F.lds + 128);
    LAS int* sel = (LAS int*)(F.lds + 256);
    LAS float* lg = (LAS float*)(F.lds + 2048);
    LAS float* linv = (LAS float*)(F.lds + 2048 + 4096);
    LAS float* Op = (LAS float*)(F.lds + 8192);
    const float* sc = WSP(float, WS_SSC) + (size_t)qi * SSCLD;
    LAS float* redf = (LAS float*)(F.lds + 1536);
    float key[17]; const float qnan = __builtin_nanf("");
#pragma unroll
    for (int e = 0; e < 17; ++e) { const int idx = tid + 512 * e; key[e] = qnan; if (idx < LTOT) { const float x = sc[idx]; key[e] = (x == -__builtin_inff()) ? qnan : x; } }
    if (tid == 0) cntw[0] = 0;
    float lo = key[0], hi = key[0];
#pragma unroll
    for (int e = 1; e < 17; ++e) { lo = fminf(lo, key[e]); hi = fmaxf(hi, key[e]); }
    lo = wmin_f(lo); hi = wmax_f(hi);
    if (lane == 0) { redf[2 * wave] = lo; redf[2 * wave + 1] = hi; }
    __syncthreads();
#pragma unroll
    for (int w = 0; w < 8; ++w) { lo = fminf(lo, redf[2 * w]); hi = fmaxf(hi, redf[2 * w + 1]); }
    float thr = lo;
    for (int it = 0; it < 32; ++it) {
        const float q2 = 0.5f * lo + 0.5f * hi, q1 = 0.5f * lo + 0.5f * q2, q3 = 0.5f * q2 + 0.5f * hi;
        if (!(q2 > lo && q2 < hi)) break;
        int c12 = 0, c3 = 0;
#pragma unroll
        for (int e = 0; e < 17; ++e) { c12 += ((key[e] >= q1) ? 1 : 0) + ((key[e] >= q2) ? 65536 : 0); c3 += (key[e] >= q3) ? 1 : 0; }
        c12 = wsum_i(c12); c3 = wsum_i(c3);
        LAS int* rb = red + (it & 1) * 16;
        if (lane == 0) { rb[wave] = c12; rb[8 + wave] = c3; }
        __syncthreads();
        int t12 = 0, t3 = 0;
#pragma unroll
        for (int w = 0; w < 8; ++w) { t12 += rb[w]; t3 += rb[8 + w]; }
        const int t1 = t12 & 65535, t2 = t12 >> 16;
        if (t3 >= 256) { lo = q3; thr = q3; if (t3 == 256) break; }
        else if (t2 >= 256) { lo = q2; hi = q3; thr = q2; if (t2 == 256) break; }
        else if (t1 >= 256) { lo = q1; hi = q2; thr = q1; if (t1 == 256) break; }
        else hi = q1;
    }
    __syncthreads();
#pragma unroll
    for (int e = 0; e < 17; ++e) if (key[e] >= thr) { const int pos = atomicAdd((int*)cntw, 1); if (pos < 256) sel[pos] = tid + 512 * e; }
    __syncthreads();
    const int nsel = cntw[0] < 256 ? cntw[0] : 256;
    const int* pt = (const int*)A.in[7] + db * NPAGES;
    const int half = lane >> 5, l32 = lane & 31;
    long long roff = 0;
    { const int si = 32 * wave + l32; const int sk = (si < nsel) ? sel[si] : 0;
      roff = (sk < PAST) ? ((long long)pt[sk >> 7] * 128 + (sk & 127)) * 256 : -(long long)(1 + sk - PAST); }
    float qv[4][4];
    { const bf16* qp = WSP(bf16, WS_QB) + (size_t)(MP + qi) * 1024 + (4 * grp) * 128 + 4 * l32;
#pragma unroll
      for (int hq = 0; hq < 4; ++hq) { const v2u q2 = *(const GAS v2u*)(qp + hq * 128); qv[hq][0] = blo(q2.x); qv[hq][1] = bhi(q2.x); qv[hq][2] = blo(q2.y); qv[hq][3] = bhi(q2.y); } }
    f32x4 vv[16];
    {
        f32x4 kv[16];
#pragma unroll
        for (int kk = 0; kk < 16; ++kk) { const long long ro = half ? readlane64(roff, 2 * kk + 1) : readlane64(roff, 2 * kk);
            const float* kr = (ro >= 0) ? A.in[2] + ro : F.out + O_KS + (size_t)(db * DSEQ + (-ro - 1)) * 256;
            const float* vr = (ro >= 0) ? A.in[3] + ro : F.out + O_VS + (size_t)(db * DSEQ + (-ro - 1)) * 256;
            kv[kk] = *(const GAS f32x4*)(kr + grp * 128 + 4 * l32); vv[kk] = *(const GAS f32x4*)(vr + grp * 128 + 4 * l32); }
#pragma unroll
        for (int kk = 0; kk < 16; ++kk) { const int si = 32 * wave + 2 * kk + half;
#pragma unroll
            for (int hq = 0; hq < 4; ++hq) { float p = qv[hq][0] * kv[kk].x + qv[hq][1] * kv[kk].y + qv[hq][2] * kv[kk].z + qv[hq][3] * kv[kk].w;
                p = half_sum_f(p);
                if (l32 == 0) lg[hq * 256 + si] = (si < nsel) ? p : -1e30f; } }
    }
    __syncthreads();
    if (wave < 4) {
        float x[4]; float mx = -1e30f;
#pragma unroll
        for (int e = 0; e < 4; ++e) { x[e] = lg[wave * 256 + lane + 64 * e]; mx = fmaxf(mx, x[e]); }
        mx = wmax_f(mx); float sum = 0.f;
#pragma unroll
        for (int e = 0; e < 4; ++e) { const float p = (lane + 64 * e < nsel) ? __builtin_amdgcn_exp2f(x[e] - mx) : 0.f; lg[wave * 256 + lane + 64 * e] = p; sum += p; }
        sum = wsum_f(sum); if (lane == 0) linv[wave] = 1.0f / sum;
    }
    __syncthreads();
    {
        float acc[4][4];
#pragma unroll
        for (int hq = 0; hq < 4; ++hq)
#pragma unroll
            for (int e = 0; e < 4; ++e) acc[hq][e] = 0.f;
#pragma unroll
        for (int kk = 0; kk < 16; ++kk) { const int si = 32 * wave + 2 * kk + half;
#pragma unroll
            for (int hq = 0; hq < 4; ++hq) { const float p = lg[hq * 256 + si]; acc[hq][0] += p * vv[kk].x; acc[hq][1] += p * vv[kk].y; acc[hq][2] += p * vv[kk].z; acc[hq][3] += p * vv[kk].w; } }
#pragma unroll
        for (int hq = 0; hq < 4; ++hq) {
#pragma unroll
            for (int e = 0; e < 4; ++e) acc[hq][e] = swap32_sum(acc[hq][e]);
            if (half == 0) *(LAS f32x4*)(Op + wave * 512 + hq * 128 + 4 * l32) = (f32x4){acc[hq][0], acc[hq][1], acc[hq][2], acc[hq][3]}; }
    }
    __syncthreads();
    { float sres = 0.f;
#pragma unroll
      for (int w = 0; w < 8; ++w) sres += Op[w * 512 + tid];
      WSP(bf16, WS_BOUT)[(size_t)(MP + qi) * 1024 + grp * 512 + tid] = (bf16)f2bf(sres * linv[tid >> 7]); }
    __syncthreads();
}
#ifndef P7_REP_S
#define P7_REP_S 0
#endif
#ifndef P7_REP_A
#define P7_REP_A 0
#endif
__device__ __forceinline__ void p7_mix_b(Frame& F, const Args& A) {
    for (int rr = 0; rr <= P7_REP_S; ++rr)
    for (int it = F.vcu; it < 2 * MS; it += F.G) attn_sample_item(F, A, it);
    for (int rr = 0; rr <= P7_REP_A; ++rr)
    for (int it = F.vcu; it < 256; it += F.G) { const int b = it >> 6, g = (it >> 5) & 1, p = it & 31; for (int rep = 0; rep < 2; ++rep) attn_block(F, b, g, rep ? 63 - p : p); }
}
constexpr int LDS_RS = 131072;
__device__ __forceinline__ const LAS _Float16* make_rowscale(Frame& F, const float* ssq) {
    LAS _Float16* t = (LAS _Float16*)(F.lds + LDS_RS);
    typedef _Float16 h4_t __attribute__((ext_vector_type(4)));
    for (int i = F.tid; i < MPAD / 4; i += NWAVES * 64) { const f32x4 q = ((const GAS f32x4*)ssq)[i];
        h4_t o; o.x = (_Float16)(1.0f / sqrtf(q.x * (1.0f / D) + EPS)); o.y = (_Float16)(1.0f / sqrtf(q.y * (1.0f / D) + EPS)); o.z = (_Float16)(1.0f / sqrtf(q.z * (1.0f / D) + EPS)); o.w = (_Float16)(1.0f / sqrtf(q.w * (1.0f / D) + EPS));
        *(LAS h4_t*)(t + 4 * i) = o; }
    __syncthreads();
    return t;
}
#ifndef MK_N_LAUNCHES
#define MK_N_LAUNCHES 1
#endif
constexpr int NPH = 16;
constexpr int N_LAUNCHES = MK_N_LAUNCHES;
__global__ void __launch_bounds__(NWAVES * 64, 2) mk_fwd(Args args) {
    extern __shared__ __attribute__((aligned(16))) unsigned char lds_raw[];
    Frame F;
    F.lds = (LAS unsigned char*)lds_raw;
    F.MISC = (volatile LAS unsigned*)(F.lds + LDS_MISC);
    F.tid = threadIdx.x; F.lane = F.tid & 63; F.wave = __builtin_amdgcn_readfirstlane(F.tid >> 6);
    F.G = gridDim.x; { const int bx = blockIdx.x; F.vcu = (F.G % 8 == 0) ? (bx % 8) * (F.G / 8) + bx / 8 : bx; }
    F.gw = F.vcu * NWAVES + F.wave; F.NGW = F.G * NWAVES;
    F.out = args.out; F.ws = args.ws; F.ctl = (unsigned*)(args.ws + WS_CTL);
    for (int u = F.tid; u < 64; u += NWAVES * 64) ((LAS unsigned*)(F.lds + LDS_MISC))[u] = 0u;
    __syncthreads();
    XcdBarrier bar; bar.bar = F.ctl + CW_BAR; bar.x = 0; bar.st = nullptr;
    if (N_LAUNCHES == 1) bar = xcd_barrier_post(F.ctl + CW_BAR, F.MISC + 8);
#define GRID_BAR() do { if (N_LAUNCHES == 1) xcd_barrier(bar); } while (0)
    const int lo = args.ph_lo, hi = args.ph_hi;
#ifndef PHASE_MASK
#define PHASE_MASK 0xffff
#endif
#ifndef REPEAT_MASK
#define REPEAT_MASK 0
#endif
#define RPT(k) (((REPEAT_MASK) >> (k)) & 1)
#define IN(k) ((((PHASE_MASK) >> (k)) & 1) && lo <= (k) && (k) < hi)
    const Args& A = args;
    if (IN(0)) _Pragma("unroll") for (int rep_ = 0; rep_ <= RPT(0); ++rep_) { p0_prologue(F, A); GRID_BAR(); }
    if (IN(1)) _Pragma("unroll") for (int rep_ = 0; rep_ <= RPT(1); ++rep_) { pg8::Gemm g{D, D}; pg8::MixOrder S; S.init(33, NGU / 256, F.G, (int)blockIdx.x, 1, D / 64, 0, 0, WSP(bf16, WS_XN), WSP(bf16, WS_W1GU), nullptr, nullptr, D, D);
        pg8::EpiSwiglu E{WSP(bf16, WS_H), FF, nullptr};
        pg8::gemm_phase<pg8::EpiSwiglu, pg8::MixOrder, true, true>(F.lds, g, S, E);
        { const int full = S.so.nwg - (S.so.nwg / F.G) * F.G;
          if ((int)blockIdx.x >= full && rep_ == 0) for (int it = CV_MAIN + ((int)blockIdx.x - full) * NWAVES + F.wave; it < CV_SMALL; it += (F.G - full) * NWAVES) conv_item(F, A, it); }
        GRID_BAR(); }
    if (IN(2)) _Pragma("unroll") for (int rep_ = 0; rep_ <= RPT(2); ++rep_) { pg8::Gemm g{FF, FF}; pg8::MixOrder S; S.init(32, D / 256, F.G, (int)blockIdx.x, 1, FF / 64, 22, 4, WSP(bf16, WS_H), WSP(bf16, WS_W1D), nullptr, nullptr, FF, FF);
        pg8::EpiResNorm E{A.in[0], WSP(float, WS_X1), WSP(bf16, WS_XN), (float*)(F.ctl + CW_SSQ1), D, 0.5f, WSP(float, WS_SLAB), A.in[1], WSP(float, WS_X1) + (size_t)MP * D, F.ctl + CW_CNT, F.ctl + CW_BAR + XB_TMO, 22};
        pg8::gemm_phase<pg8::EpiResNorm, pg8::MixOrder, true, true>(F.lds, g, S, E);
        if ((int)blockIdx.x >= 176 && rep_ == 0) conv_item(F, A, C2 + ((int)blockIdx.x - 176) * NWAVES + F.wave);
        GRID_BAR(); }
    if (IN(4)) _Pragma("unroll") for (int rep_ = 0; rep_ <= RPT(4); ++rep_) { pg8::Gemm g{D, D}; pg8::MixOrder S; S.init(33, NINP / 256, F.G, (int)blockIdx.x, 1, D / 64, 0, 0, WSP(bf16, WS_XN), WSP(bf16, WS_WIN), nullptr, nullptr, D, D);
        pg8::EpiBf16Plain E{WSP(bf16, WS_Z), NINP, make_rowscale(F, (const float*)(F.ctl + CW_SSQ1))};
        pg8::gemm_phase<pg8::EpiBf16Plain, pg8::MixOrder, true, true>(F.lds, g, S, E); GRID_BAR(); }
    if (IN(5)) _Pragma("unroll") for (int rep_ = 0; rep_ <= RPT(5); ++rep_) { p5_post(F, A); GRID_BAR(); }
    if (IN(6)) _Pragma("unroll") for (int rep_ = 0; rep_ <= RPT(6); ++rep_) { p6_mix_a(F, A); GRID_BAR(); }
    if (IN(7)) _Pragma("unroll") for (int rep_ = 0; rep_ <= RPT(7); ++rep_) { p7_mix_b(F, A); GRID_BAR(); }
    if (IN(8)) _Pragma("unroll") for (int rep_ = 0; rep_ <= RPT(8); ++rep_) { pg8::Gemm g{1024, 1024}; pg8::GluBOrder S; S.init(F.G, (int)blockIdx.x, WSP(bf16, WS_ZA), WSP(bf16, WS_WGLU), WSP(bf16, WS_BOUT), WSP(bf16, WS_WB));
        pg8::EpiGluB E{WSP(bf16, WS_AOUT), WSP(bf16, WS_ZA), A.in[25], WSP(bf16, WS_TMPG), WSP(bf16, WS_Z) + ZGB, NINP, WSP(float, WS_PBS)};
        pg8::gemm_phase<pg8::EpiGluB, pg8::GluBOrder, true, true>(F.lds, g, S, E);
        if ((int)blockIdx.x >= 164 && rep_ == 0) for (int it = CV_CARVE + ((int)blockIdx.x - 164) * NWAVES + F.wave; it < 4 * I_GU; it += (F.G - 164) * NWAVES) conv_item(F, A, it);
        GRID_BAR(); }
    if (IN(9)) _Pragma("unroll") for (int rep_ = 0; rep_ <= RPT(9); ++rep_) { pg8::Gemm g{1024, 1024}; pg8::MixOrder S; S.init(32, D / 256, F.G, (int)blockIdx.x, 1, 16, 4, 4, WSP(bf16, WS_AOUT), WSP(bf16, WS_WA), nullptr, nullptr, 1024, 1024);
        pg8::EpiBranchA E{WSP(bf16, WS_TMPG), WSP(bf16, WS_MERGED), D, WSP(bf16, WS_Z) + ZGA, NINP, WSP(float, WS_PAS)};
        pg8::gemm_phase<pg8::EpiBranchA, pg8::MixOrder, true, true>(F.lds, g, S, E);
        if ((int)blockIdx.x >= 32 && rep_ == 0) conv_item(F, A, C9 + ((int)blockIdx.x - 32) * NWAVES + F.wave);
        GRID_BAR(); }
    if (IN(11)) _Pragma("unroll") for (int rep_ = 0; rep_ <= RPT(11); ++rep_) {
        if ((int)blockIdx.x < 64) { const int kq = (int)blockIdx.x >> 3; const float* PAs = WSP(float, WS_PAS); const float* PBs = WSP(float, WS_PBS); const bf16* Z = WSP(bf16, WS_Z);
            for (int ch = F.tid; ch < 128 * 32; ch += NWAVES * 64) { const int r = ch >> 5, c = kq * 256 + (ch & 31) * 8;
                const v4u gaw = *(const GAS v4u*)(Z + (size_t)(MP + r) * NINP + ZGA + c), gbw = *(const GAS v4u*)(Z + (size_t)(MP + r) * NINP + ZGB + c);
                f32x4 pa0 = {0.f, 0.f, 0.f, 0.f}, pa1 = pa0, pb0 = pa0, pb1 = pa0;
#pragma unroll
                for (int k = 0; k < 4; ++k) { const size_t o = ((size_t)k * 128 + r) * D + c;
                    pa0 = pa0 + *(const GAS f32x4*)(PAs + o); pa1 = pa1 + *(const GAS f32x4*)(PAs + o + 4); pb0 = pb0 + *(const GAS f32x4*)(PBs + o); pb1 = pb1 + *(const GAS f32x4*)(PBs + o + 4); }
                const float ga[8] = {blo(gaw.x), bhi(gaw.x), blo(gaw.y), bhi(gaw.y), blo(gaw.z), bhi(gaw.z), blo(gaw.w), bhi(gaw.w)}, gb[8] = {blo(gbw.x), bhi(gbw.x), blo(gbw.y), bhi(gbw.y), blo(gbw.z), bhi(gbw.z), blo(gbw.w), bhi(gbw.w)};
                const float pa[8] = {pa0.x, pa0.y, pa0.z, pa0.w, pa1.x, pa1.y, pa1.z, pa1.w}, pb[8] = {pb0.x, pb0.y, pb0.z, pb0.w, pb1.x, pb1.y, pb1.z, pb1.w};
                float o[8];
#pragma unroll
                for (int e = 0; e < 8; ++e) o[e] = pg8::sigm(ga[e]) * pa[e] + pg8::sigm(gb[e]) * pb[e];
                v4u w; w.x = pk2(o[0], o[1]); w.y = pk2(o[2], o[3]); w.z = pk2(o[4], o[5]); w.w = pk2(o[6], o[7]);
                *(GAS v4u*)(WSP(bf16, WS_MERGED) + (size_t)(MP + r) * D + c) = w; }
            VM_WAIT(); __syncthreads(); }
        pg8::Gemm g{D, D}; pg8::MixOrder S; S.init(32, D / 256, F.G, (int)blockIdx.x, 1, D / 64, 8, 4, WSP(bf16, WS_MERGED), WSP(bf16, WS_WOUT), nullptr, nullptr, D, D);
        pg8::EpiResNorm E{WSP(float, WS_X1), WSP(float, WS_X2), WSP(bf16, WS_XN), (float*)(F.ctl + CW_SSQ2), D, 1.0f, WSP(float, WS_SLAB2), WSP(float, WS_X1) + (size_t)MP * D, WSP(float, WS_X2) + (size_t)MP * D, F.ctl + CW_CNT + 512, F.ctl + CW_BAR + XB_TMO, 8};
        pg8::gemm_phase<pg8::EpiResNorm, pg8::MixOrder, true, true>(F.lds, g, S, E);
        if ((int)blockIdx.x >= 64 && rep_ == 0) conv_item(F, A, C11 + ((int)blockIdx.x - 64) * NWAVES + F.wave);
        GRID_BAR(); }
    if (IN(13)) _Pragma("unroll") for (int rep_ = 0; rep_ <= RPT(13); ++rep_) { pg8::Gemm g{D, D}; pg8::MixOrder S; S.init(33, NGU / 256, F.G, (int)blockIdx.x, 1, D / 64, 0, 0, WSP(bf16, WS_XN), WSP(bf16, WS_W2GU), nullptr, nullptr, D, D);
        pg8::EpiSwiglu E{WSP(bf16, WS_H), FF, make_rowscale(F, (const float*)(F.ctl + CW_SSQ2))};
        pg8::gemm_phase<pg8::EpiSwiglu, pg8::MixOrder, true, true>(F.lds, g, S, E);
        { const int full = S.so.nwg - (S.so.nwg / F.G) * F.G;
          if ((int)blockIdx.x >= full && rep_ == 0) for (int it = CV_SMALL + ((int)blockIdx.x - full) * NWAVES + F.wave; it < CV_END; it += (F.G - full) * NWAVES) conv_item(F, A, it); }
        GRID_BAR(); }
    if (IN(14)) _Pragma("unroll") for (int rep_ = 0; rep_ <= RPT(14); ++rep_) { pg8::Gemm g{FF, FF}; pg8::MixOrder S; S.init(32, D / 256, F.G, (int)blockIdx.x, 1, FF / 64, 22, 4, WSP(bf16, WS_H), WSP(bf16, WS_W2D), nullptr, nullptr, FF, FF);
        pg8::EpiResNorm E{WSP(float, WS_X2), F.out, nullptr, nullptr, D, 0.5f, WSP(float, WS_SLAB3), WSP(float, WS_X2) + (size_t)MP * D, F.out + O_YS, F.ctl + CW_CNT + 1024, F.ctl + CW_BAR + XB_TMO, 22};
        pg8::gemm_phase<pg8::EpiResNorm, pg8::MixOrder, true, true>(F.lds, g, S, E); }
#undef IN
}

extern "C" void kernel_launch(void* const* d_in, const int* in_sizes, int n_in, void* d_out, int out_size, void* d_ws, size_t ws_size, hipStream_t stream) {
    static int grid = 0;
    if (grid == 0) {
        if (n_in != 33 || out_size != (int)O_END || ws_size < WS_END) { fprintf(stderr, "kernel_launch: unexpected sizes (n_in %d, out %d, ws %zu); nothing launched\n", n_in, out_size, ws_size); grid = -1; return; }
        int dev = 0, cus = 0, per_cu = 0;
        if (hipGetDevice(&dev) != hipSuccess || hipDeviceGetAttribute(&cus, hipDeviceAttributeMultiprocessorCount, dev) != hipSuccess) { grid = -1; return; }
        if (hipFuncSetAttribute((const void*)mk_fwd, hipFuncAttributeMaxDynamicSharedMemorySize, LDS_BYTES) != hipSuccess) { fprintf(stderr, "kernel_launch: hipFuncSetAttribute failed\n"); grid = -1; return; }
        if (hipOccupancyMaxActiveBlocksPerMultiprocessor(&per_cu, (const void*)mk_fwd, NWAVES * 64, LDS_BYTES) != hipSuccess || per_cu < 1)
            fprintf(stderr, "kernel_launch: note: occupancy query reports %d workgroups per CU\n", per_cu);
        (void)hipGetLastError();
        grid = cus;
        if (cus != 256) { fprintf(stderr, "kernel_launch: built for a 256-CU device (every workgroup owns at most one split-K unit of the sample tile); this device has %d CUs; nothing launched\n", cus); grid = -1; return; }
    }
    if (grid < 0) return;
    if (hipMemsetAsync((char*)d_ws + WS_CTL, 0, CTL_ZERO_BYTES, stream) != hipSuccess) return;
    Args a{};
    for (int i = 0; i < 33; ++i) a.in[i] = (const float*)d_in[i];
    a.out = (float*)d_out; a.ws = (unsigned char*)d_ws;
    for (int li = 0; li < N_LAUNCHES; ++li) {
        a.ph_lo = (N_LAUNCHES == 1) ? 0 : li; a.ph_hi = (N_LAUNCHES == 1) ? NPH : li + 1;
        hipLaunchKernelGGL(mk_fwd, dim3(grid), dim3(NWAVES * 64), LDS_BYTES, stream, a);
        const hipError_t le = hipPeekAtLastError();
        if (le != hipSuccess) { fprintf(stderr, "kernel_launch: launch %d failed: %s\n", li, hipGetErrorName(le)); break; }
    }
}
```

```cpp
#include <hip/hip_runtime.h>
#include <cstdio>
#include <cstdint>
namespace pg8 {
#define PG8_LAS __attribute__((address_space(3)))
typedef unsigned short bf16_t;
typedef short bf16x8 __attribute__((ext_vector_type(8)));
typedef float f32x4 __attribute__((ext_vector_type(4)));
typedef unsigned u32x4 __attribute__((ext_vector_type(4)));
constexpr int BM = 256, BK = 64, HALF = 128, HTB = HALF * BK * 2  , STAGE_BYTES = 8 * HTB, NXCD = 8, WGM = 8;

__host__ __device__ __forceinline__ int lds_byte(int r, int c) { const int st = (r >> 4) * 2 + (c >> 5), rr = r & 15, cc = c & 31, ob = rr * 64 + cc * 2; return st * 1024 + (ob ^ (((ob >> 9) & 1) << 5)); }
__host__ __device__ __forceinline__ void stage_rc(int b, int& R, int& C) { const int st = b / 1024, sb = b % 1024, swz = sb ^ (((sb >> 9) & 1) << 5); R = (st >> 1) * 16 + swz / 64; C = (st & 1) * 32 + (swz % 64) / 2; }
__host__ __device__ __forceinline__ int perm32(int rho) { const int n = rho >> 4, i = rho & 15; return 8 * (i >> 2) + 4 * n + (i & 3); }

struct Unit { int pm, pn, tag, nt, kq, pad_; const char* a; const char* b; };
struct Gemm { int lda, ldb; };

struct StaticOrder {
    int nM, nN, nwg, G, c;
    __host__ __device__ void init(int M, int N, int G_, int c_) { nM = M / BM; nN = N / BM; nwg = nM * nN; G = G_; c = c_; }
    __host__ __device__ bool next(int i, Unit& u) const { return tile((long)i * G + c, u); }
    __host__ __device__ bool tile(long L, Unit& u) const {
        if (L >= nwg) return false;
        int wgid = (int)L; { const int q = nwg / NXCD, r = nwg % NXCD, xcd = wgid % NXCD, off = wgid / NXCD; wgid = (xcd < r ? xcd * (q + 1) : r * (q + 1) + (xcd - r) * q) + off; }
        const int nig = WGM * nN, gid = wgid / nig, fm = gid * WGM, gsz = (nM - fm) < WGM ? (nM - fm) : WGM;
        u.pm = fm + ((wgid % nig) % gsz); u.pn = (wgid % nig) / gsz; return true;
    }
    __device__ __forceinline__ void a_ready(const Unit&) const {}
    __device__ __forceinline__ void done(const Unit&) const {}
};

struct MixOrder {
    StaticOrder so; int ntag, ntp, S, nts, nN, G, c, npc;
    const char* a0; const char* a1; const char* b0; const char* b1; size_t tA, tB;
    __device__ __forceinline__ void init(int nMp, int nN_, int G_, int c_, int ntag_, int ntp_, int S_, int nts_, const void* A0, const void* B0, const void* A1, const void* B1, int lda, int ldb) {
        so.init(nMp * BM, nN_ * BM, G_, c_); ntag = ntag_; ntp = ntp_; S = S_; nts = nts_; nN = nN_; G = G_; c = c_;
        npc = (so.nwg > c_) ? (so.nwg - 1 - c_) / G_ + 1 : 0;
        a0 = (const char*)A0; a1 = (const char*)A1; b0 = (const char*)B0; b1 = (const char*)B1; tA = (size_t)BM * lda * 2; tB = (size_t)BM * ldb * 2;
    }
    __device__ __forceinline__ bool next(int i, Unit& u) const {
        if (i < npc * ntag) { const int r = i / ntag, tg = i - r * ntag; so.next(r, u); u.tag = tg; u.nt = ntp; u.kq = 0;
            u.a = (tg ? a1 : a0) + (size_t)u.pm * tA; u.b = (tg ? b1 : b0) + (size_t)u.pn * tB; return true; }
        const int j = (i - npc * ntag) * G + c, per = nN * S;
        if (j >= ntag * per) return false;
        const int tg = j / per, rem = j - tg * per, kq = rem / nN; u.pm = 32; u.pn = rem - kq * nN; u.tag = tg | 4; u.nt = nts; u.kq = kq;
        u.a = (tg ? a1 : a0) + (size_t)32 * tA + (size_t)kq * nts * (BK * 2); u.b = (tg ? b1 : b0) + (size_t)u.pn * tB + (size_t)kq * nts * (BK * 2); return true;
    }
    __device__ __forceinline__ void a_ready(const Unit&) const {}
    __device__ __forceinline__ void done(const Unit&) const {}
};

struct GluBOrder {
    StaticOrder sb; int G, c; const char* za; const char* wg; const char* bo; const char* wb; size_t tA, tB;
    __device__ __forceinline__ void init(int G_, int c_, const void* ZA, const void* WG, const void* BO, const void* WB) {
        sb.init(32 * BM, 8 * BM, G_, 0); G = G_; c = c_; za = (const char*)ZA; wg = (const char*)WG; bo = (const char*)BO; wb = (const char*)WB; tA = (size_t)BM * 1024 * 2; tB = tA; }
    __device__ __forceinline__ bool next(int i, Unit& u) const {
        const int L = i * G + c; u.kq = 0; u.pad_ = 0;
        if (L < 132) { u.pm = L >> 2; u.pn = L & 3; u.tag = 0; u.nt = 16; u.a = za + (size_t)u.pm * tA; u.b = wg + (size_t)u.pn * tB; return true; }
        if (L < 388) { sb.tile(L - 132, u); u.tag = 1; u.nt = 16; u.a = bo + (size_t)u.pm * tA; u.b = wb + (size_t)u.pn * tB; return true; }
        const int j = L - 388; if (j >= 32) return false;
        u.kq = j >> 3; u.pn = j & 7; u.pm = 32; u.tag = 5; u.nt = 4; u.a = bo + (size_t)32 * tA + (size_t)u.kq * 4 * (BK * 2); u.b = wb + (size_t)u.pn * tB + (size_t)u.kq * 4 * (BK * 2); return true;
    }
    __device__ __forceinline__ void a_ready(const Unit&) const {}
    __device__ __forceinline__ void done(const Unit&) const {}
};

__device__ __forceinline__ unsigned cvt_pk_bf16(float lo, float hi) { typedef float f2_t __attribute__((ext_vector_type(2))); typedef __bf16 b2_t __attribute__((ext_vector_type(2))); const f2_t v = {lo, hi}; return __builtin_bit_cast(unsigned, __builtin_convertvector(v, b2_t)); }
typedef float f32x2 __attribute__((ext_vector_type(2)));
__device__ __forceinline__ float sigm(float x) { return __builtin_amdgcn_rcpf(1.f + __builtin_amdgcn_exp2f(-1.4426950409f * x)); }
__device__ __forceinline__ float bflo(unsigned w) { return __uint_as_float(w << 16); }
__device__ __forceinline__ float bfhi(unsigned w) { return __uint_as_float(w & 0xffff0000u); }
typedef __amdgpu_buffer_rsrc_t rsrc_t;
__device__ __forceinline__ rsrc_t mkrsrc(const void* base) { return __builtin_amdgcn_make_buffer_rsrc((void*)base, 0, 0x7fffffff, 0x00020000); }
__device__ __forceinline__ void st16wt(rsrc_t r, size_t byteoff, f32x4 v) { __builtin_amdgcn_raw_buffer_store_b128(__builtin_bit_cast(u32x4, v), r, (int)byteoff, 0, 16); }
constexpr int PAD_TILE = 32;
struct EpiSwiglu {
    static constexpr bool PERM = true, AFTER_DRAIN = false;
    bf16_t* H; int ldh; const PG8_LAS _Float16* rsl;
    __device__ __forceinline__ void operator()(const f32x4 (&acc)[2][2][4][2], const Unit& u, int wr, int wc, int fr, int fq) const {
        const int row0 = u.pm * BM + wr * 64 + fr, col0 = u.pn * HALF + wc * 32 + 8 * fq;
#pragma unroll
        for (int ai = 0; ai < 2; ++ai)
#pragma unroll
            for (int m = 0; m < 4; ++m) { bf16_t* rowp = H + (size_t)(row0 + ai * HALF + m * 16) * ldh + col0;
                const float rs = rsl ? (float)rsl[row0 + ai * HALF + m * 16] : 1.0f;
                float v[8];
#pragma unroll
                for (int n = 0; n < 2; ++n)
#pragma unroll
                    for (int e = 0; e < 4; ++e) { const float g = acc[ai][0][m][n][e] * rs, up = acc[ai][1][m][n][e] * rs; v[4 * n + e] = g * up * sigm(g); }
                u32x4 w; w.x = cvt_pk_bf16(v[0], v[1]); w.y = cvt_pk_bf16(v[2], v[3]); w.z = cvt_pk_bf16(v[4], v[5]); w.w = cvt_pk_bf16(v[6], v[7]);
                *(u32x4*)rowp = w; }
    }
};
struct EpiResNorm {
    static constexpr bool PERM = true, AFTER_DRAIN = true;
    const float* baseP; float* out; bf16_t* xn; float* ssq; int ldc; float scale;
    float* slab; const float* baseS; float* outS; unsigned* cnt; unsigned* tmo; int S;
    __device__ __forceinline__ void operator()(const f32x4 (&acc)[2][2][4][2], const Unit& u, int wr, int wc, int fr, int fq) const {
        const int col0 = u.pn * BM + wc * 32 + 8 * fq;
#pragma unroll
        for (int ai = 0; ai < 2; ++ai)
#pragma unroll
            for (int m = 0; m < 4; ++m) { const int row = u.pm * BM + ai * HALF + wr * 64 + m * 16 + fr; const size_t op = (size_t)row * ldc; float sq = 0.f;
#pragma unroll
                for (int bj = 0; bj < 2; ++bj) { const int c = col0 + bj * HALF;
                    const f32x4 o0 = *(const f32x4*)(baseP + op + c) + acc[ai][bj][m][0] * scale, o1 = *(const f32x4*)(baseP + op + c + 4) + acc[ai][bj][m][1] * scale;
                    *(f32x4*)(out + op + c) = o0; *(f32x4*)(out + op + c + 4) = o1;
                    if (xn) { u32x4 w; w.x = cvt_pk_bf16(o0[0], o0[1]); w.y = cvt_pk_bf16(o0[2], o0[3]); w.z = cvt_pk_bf16(o1[0], o1[1]); w.w = cvt_pk_bf16(o1[2], o1[3]); *(u32x4*)(xn + op + c) = w;
                        sq += ((o0[0] * o0[0] + o0[1] * o0[1]) + (o0[2] * o0[2] + o0[3] * o0[3])) + ((o1[0] * o1[0] + o1[1] * o1[1]) + (o1[2] * o1[2] + o1[3] * o1[3])); } }
                if (xn) {
                    { auto r1 = __builtin_amdgcn_permlane16_swap(__float_as_uint(sq), __float_as_uint(sq), false, false); sq = __uint_as_float(r1[0]) + __uint_as_float(r1[1]); }
                    { auto r2 = __builtin_amdgcn_permlane32_swap(__float_as_uint(sq), __float_as_uint(sq), false, false); sq = __uint_as_float(r2[0]) + __uint_as_float(r2[1]); }
                    if (fq == 0) __hip_atomic_fetch_add(ssq + row, sq, __ATOMIC_RELAXED, __HIP_MEMORY_SCOPE_AGENT); } }
    }
    __device__ __forceinline__ void fused(f32x4 (&acc)[2][2][4][2], const Unit& u, int wr, int wc, int fr, int fq, PG8_LAS unsigned char* lds, int wid, int lane) const {
        if (!(u.tag & 4)) { (*this)(acc, u, wr, wc, fr, fq); }
        else {
            const int col0 = u.pn * BM + wc * 32 + 8 * fq; const rsrc_t rs = mkrsrc(slab);
#pragma unroll
            for (int m = 0; m < 4; ++m) { const size_t op = ((size_t)u.kq * HALF + wr * 64 + m * 16 + fr) * ldc + col0;
#pragma unroll
                for (int bj = 0; bj < 2; ++bj) { st16wt(rs, (op + bj * HALF) * 4, acc[0][bj][m][0]); st16wt(rs, (op + bj * HALF + 4) * 4, acc[0][bj][m][1]); } }
            asm volatile("s_waitcnt vmcnt(0)" ::: "memory"); __syncthreads();
            if (threadIdx.x == 0) {
                unsigned* cw = cnt + 64 * u.pn; __hip_atomic_fetch_add(cw, 1u, __ATOMIC_RELAXED, __HIP_MEMORY_SCOPE_AGENT);
                unsigned sp = 0u;
                while (__hip_atomic_load(cw, __ATOMIC_RELAXED, __HIP_MEMORY_SCOPE_AGENT) < (unsigned)S) { __builtin_amdgcn_s_sleep(2);
                    if ((++sp & 255u) == 0u) { if (__hip_atomic_load(tmo, __ATOMIC_RELAXED, __HIP_MEMORY_SCOPE_AGENT)) break; if (sp > (1u << 18)) { __hip_atomic_fetch_add(tmo, 1u, __ATOMIC_RELAXED, __HIP_MEMORY_SCOPE_AGENT); break; } } }
                __builtin_amdgcn_fence(__ATOMIC_ACQUIRE, "agent"); asm volatile("s_waitcnt vmcnt(0)" ::: "memory");
            }
            __syncthreads();
            for (int r = u.kq + S * wid; r < HALF; r += S * 8) {
                const size_t o4 = (size_t)r * ldc + u.pn * BM + 4 * lane; f32x4 a = {0.f, 0.f, 0.f, 0.f};
                for (int k = 0; k < S; ++k) a = a + *(const f32x4*)(slab + (size_t)k * HALF * ldc + o4);
                const f32x4 o = *(const f32x4*)(baseS + o4) + a * scale; *(f32x4*)(outS + o4) = o;
                if (xn) { typedef unsigned u32x2 __attribute__((ext_vector_type(2))); u32x2 w; w.x = cvt_pk_bf16(o[0], o[1]); w.y = cvt_pk_bf16(o[2], o[3]); *(u32x2*)(xn + (size_t)PAD_TILE * BM * ldc + o4) = w;
                    float sq = (o[0] * o[0] + o[1] * o[1]) + (o[2] * o[2] + o[3] * o[3]);
#pragma unroll
                    for (int of = 1; of < 64; of <<= 1) sq += __shfl_xor(sq, of);
                    if (lane == 0) __hip_atomic_fetch_add(ssq + PAD_TILE * BM + r, sq, __ATOMIC_RELAXED, __HIP_MEMORY_SCOPE_AGENT); }
            }
        }
    }
};
struct EpiBf16Plain {
    static constexpr bool PERM = true, AFTER_DRAIN = false;
    bf16_t* O; int ldc; const PG8_LAS _Float16* rsl;
    __device__ __forceinline__ void operator()(const f32x4 (&acc)[2][2][4][2], const Unit& u, int wr, int wc, int fr, int fq) const {
        const int row0 = u.pm * BM + wr * 64 + fr, col0 = u.pn * BM + wc * 32 + 8 * fq;
#pragma unroll
        for (int ai = 0; ai < 2; ++ai)
#pragma unroll
            for (int m = 0; m < 4; ++m) { bf16_t* rowp = O + (size_t)(row0 + ai * HALF + m * 16) * ldc + col0;
                const float rs = rsl ? (float)rsl[row0 + ai * HALF + m * 16] : 1.0f;
#pragma unroll
                for (int bj = 0; bj < 2; ++bj) { const f32x4 v0 = acc[ai][bj][m][0] * rs, v1 = acc[ai][bj][m][1] * rs;
                    u32x4 w; w.x = cvt_pk_bf16(v0[0], v0[1]); w.y = cvt_pk_bf16(v0[2], v0[3]); w.z = cvt_pk_bf16(v1[0], v1[1]); w.w = cvt_pk_bf16(v1[2], v1[3]);
                    *(u32x4*)(rowp + bj * HALF) = w; } }
    }
};
struct EpiGluB {
    static constexpr bool PERM = true, AFTER_DRAIN = false;
    bf16_t* AO; const bf16_t* ZA; const float* bias; bf16_t* T; const bf16_t* GB; int ldg; float* PBs;
    __device__ __forceinline__ void operator()(const f32x4 (&acc)[2][2][4][2], const Unit& u, int wr, int wc, int fr, int fq) const {
        const int row0 = u.pm * BM + wr * 64 + fr, col0 = u.pn * BM + wc * 32 + 8 * fq;
        if (u.tag & 4) { float* dst = PBs + (size_t)u.kq * HALF * 2048;
#pragma unroll
            for (int m = 0; m < 4; ++m) { float* op = dst + (size_t)(wr * 64 + m * 16 + fr) * 2048 + col0;
#pragma unroll
                for (int bj = 0; bj < 2; ++bj)
#pragma unroll
                    for (int n = 0; n < 2; ++n) *(f32x4*)(op + bj * HALF + 4 * n) = acc[0][bj][m][n]; }
        } else {
        const bool glu = u.tag == 0; const bf16_t* G = glu ? ZA : GB; const int ld = glu ? 1024 : ldg, ldo = glu ? 1024 : 2048;
#pragma unroll
        for (int ai = 0; ai < 2; ++ai)
#pragma unroll
            for (int m = 0; m < 4; ++m) { const size_t row = (size_t)(row0 + ai * HALF + m * 16);
#pragma unroll
                for (int bj = 0; bj < 2; ++bj) { const int c = col0 + bj * HALF; float o[8];
                    const u32x4 gw = *(const u32x4*)(G + row * ld + c);
                    const float g[8] = {bflo(gw.x), bfhi(gw.x), bflo(gw.y), bfhi(gw.y), bflo(gw.z), bfhi(gw.z), bflo(gw.w), bfhi(gw.w)};
                    if (glu) { const f32x4 b0 = *(const f32x4*)(bias + c), b1 = *(const f32x4*)(bias + c + 4);
#pragma unroll
                        for (int e = 0; e < 4; ++e) { o[e] = g[e] * sigm(acc[ai][bj][m][0][e] + b0[e]); o[4 + e] = g[4 + e] * sigm(acc[ai][bj][m][1][e] + b1[e]); } }
                    else {
#pragma unroll
                        for (int e = 0; e < 4; ++e) { o[e] = sigm(g[e]) * acc[ai][bj][m][0][e]; o[4 + e] = sigm(g[4 + e]) * acc[ai][bj][m][1][e]; } }
                    u32x4 w; w.x = cvt_pk_bf16(o[0], o[1]); w.y = cvt_pk_bf16(o[2], o[3]); w.z = cvt_pk_bf16(o[4], o[5]); w.w = cvt_pk_bf16(o[6], o[7]);
                    if (glu) *(u32x4*)(AO + row * ldo + c) = w; else *(u32x4*)(T + row * ldo + c) = w; } }
        }
    }
};
struct EpiBranchA {
    static constexpr bool PERM = true, AFTER_DRAIN = false;
    const bf16_t* T; bf16_t* MG; int ldo; const bf16_t* GA; int ldg; float* PAs;
    __device__ __forceinline__ void operator()(const f32x4 (&acc)[2][2][4][2], const Unit& u, int wr, int wc, int fr, int fq) const {
        const int row0 = u.pm * BM + wr * 64 + fr, col0 = u.pn * BM + wc * 32 + 8 * fq;
        if (u.tag & 4) { float* dst = PAs + (size_t)u.kq * HALF * ldo;
#pragma unroll
            for (int m = 0; m < 4; ++m) { float* op = dst + (size_t)(wr * 64 + m * 16 + fr) * ldo + col0;
#pragma unroll
                for (int bj = 0; bj < 2; ++bj)
#pragma unroll
                    for (int n = 0; n < 2; ++n) *(f32x4*)(op + bj * HALF + 4 * n) = acc[0][bj][m][n]; }
        } else {
#pragma unroll
        for (int ai = 0; ai < 2; ++ai)
#pragma unroll
            for (int m = 0; m < 4; ++m) { const size_t row = (size_t)(row0 + ai * HALF + m * 16);
#pragma unroll
                for (int bj = 0; bj < 2; ++bj) { const int c = col0 + bj * HALF; float o[8];
                    const u32x4 gw = *(const u32x4*)(GA + row * ldg + c), pw = *(const u32x4*)(T + row * ldo + c);
                    const float g[8] = {bflo(gw.x), bfhi(gw.x), bflo(gw.y), bfhi(gw.y), bflo(gw.z), bfhi(gw.z), bflo(gw.w), bfhi(gw.w)};
                    const float p[8] = {bflo(pw.x), bfhi(pw.x), bflo(pw.y), bfhi(pw.y), bflo(pw.z), bfhi(pw.z), bflo(pw.w), bfhi(pw.w)};
#pragma unroll
                    for (int e = 0; e < 4; ++e) { o[e] = p[e] + sigm(g[e]) * acc[ai][bj][m][0][e]; o[4 + e] = p[4 + e] + sigm(g[4 + e]) * acc[ai][bj][m][1][e]; }
                    u32x4 w; w.x = cvt_pk_bf16(o[0], o[1]); w.y = cvt_pk_bf16(o[2], o[3]); w.z = cvt_pk_bf16(o[4], o[5]); w.w = cvt_pk_bf16(o[6], o[7]);
                    *(u32x4*)(MG + row * ldo + c) = w; } }
        }
    }
};
template <class Epi, class Sched, bool ALIGN_EPI = false, bool SP2 = false>
__device__ __forceinline__ void gemm_phase(PG8_LAS unsigned char* lds, const Gemm g, const Sched& S, const Epi& E) {
    const int tid = threadIdx.x, wid = __builtin_amdgcn_readfirstlane(tid >> 6), lane = tid & 63, wr = wid >> 2, wc = wid & 3, fr = lane & 15, fq = lane >> 4;
    unsigned voffA[2], voffB[2];
#pragma unroll
    for (int i = 0; i < 2; ++i) { int R, C; stage_rc(tid * 16 + i * 8192, R, C); const int Rb = Epi::PERM ? ((R & ~31) + perm32(R & 31)) : R;
        voffA[i] = (unsigned)(R * g.lda + C) * 2u; voffB[i] = (unsigned)(Rb * g.ldb + C) * 2u; }
    const size_t kstep = (size_t)(BK * 2);
    const size_t hstepA = (size_t)HALF * g.lda * 2, hstepB = (size_t)HALF * g.ldb * 2;
    const unsigned ldsw = (unsigned)wid * 1024u;
    const int aoff = lds_byte(wr * 64 + fr, fq * 8), boff = lds_byte(wc * 32 + fr, fq * 8);
#define PG8_SA(b, h) (((b) * 2 + (h)) * HTB)
#define PG8_SB(b, h) ((4 + (b) * 2 + (h)) * HTB)
#define PG8_STAGE(bufoff, gbase, voff) do { _Pragma("unroll") for (int _i = 0; _i < 2; ++_i) \
        __builtin_amdgcn_global_load_lds((const unsigned*)((const char*)(gbase) + (voff)[_i]), (PG8_LAS unsigned*)(lds + (bufoff) + ldsw + _i * 8192), 16, 0, 0); } while (0)
#define PG8_LDA(dst, b, h) do { _Pragma("unroll") for (int m = 0; m < 4; ++m) _Pragma("unroll") for (int k = 0; k < 2; ++k) dst[m][k] = *(const PG8_LAS bf16x8*)(lds + PG8_SA(b, h) + aoff + m * 2048 + k * 1024); } while (0)
#define PG8_LDB(dst, b, h) do { _Pragma("unroll") for (int n = 0; n < 2; ++n) _Pragma("unroll") for (int k = 0; k < 2; ++k) dst[n][k] = *(const PG8_LAS bf16x8*)(lds + PG8_SB(b, h) + boff + n * 2048 + k * 1024); } while (0)
#define PG8_MMA(ai, bj, At, Bt) do { __builtin_amdgcn_s_setprio(1); _Pragma("unroll") for (int m = 0; m < 4; ++m) _Pragma("unroll") for (int n = 0; n < 2; ++n) _Pragma("unroll") for (int k = 0; k < 2; ++k) \
        acc[ai][bj][m][n] = __builtin_amdgcn_mfma_f32_16x16x32_bf16(Bt[n][k], At[m][k], acc[ai][bj][m][n], 0, 0, 0); __builtin_amdgcn_s_setprio(0); } while (0)
#define PG8_WAIT_V(n) asm volatile("s_waitcnt vmcnt(" #n ")" ::: "memory")
#define PG8_WAIT_L(n) asm volatile("s_waitcnt lgkmcnt(" #n ")" ::: "memory")
#define PG8_BAR __builtin_amdgcn_s_barrier()
#define PG8_SCHED __builtin_amdgcn_sched_barrier(0)
    Unit cur, nxt; int ui = 0;
    if (!S.next(0, cur)) return;
    f32x4 acc[2][2][4][2];
#pragma unroll
    for (int a = 0; a < 2; ++a)
#pragma unroll
        for (int b = 0; b < 2; ++b)
#pragma unroll
            for (int m = 0; m < 4; ++m)
#pragma unroll
                for (int n = 0; n < 2; ++n) acc[a][b][m][n] = (f32x4){0.f, 0.f, 0.f, 0.f};
    bf16x8 At[4][2], B0[2][2], B1[2][2];
    const char* cA = cur.a; const char* cB = cur.b;
    S.a_ready(cur);
    if constexpr (SP2) {
        PG8_STAGE(PG8_SB(0, 0), cB, voffB); PG8_STAGE(PG8_SB(0, 1), cB + hstepB, voffB); PG8_STAGE(PG8_SA(0, 0), cA, voffA); PG8_STAGE(PG8_SA(0, 1), cA + hstepA, voffA);
        if (wr == 1) PG8_BAR;
        PG8_WAIT_V(2); PG8_BAR;
        PG8_STAGE(PG8_SB(1, 0), cB + kstep, voffB); PG8_STAGE(PG8_SA(1, 0), cA + kstep, voffA); PG8_STAGE(PG8_SB(1, 1), cB + hstepB + kstep, voffB);
        PG8_WAIT_V(6); PG8_BAR;
    } else {
        PG8_STAGE(PG8_SB(0, 0), cB, voffB); PG8_STAGE(PG8_SA(0, 0), cA, voffA); PG8_STAGE(PG8_SB(0, 1), cB + hstepB, voffB); PG8_STAGE(PG8_SA(0, 1), cA + hstepA, voffA);
        if (wr == 1) PG8_BAR;
        PG8_WAIT_V(4); PG8_BAR;
        PG8_STAGE(PG8_SB(1, 0), cB + kstep, voffB); PG8_STAGE(PG8_SA(1, 0), cA + kstep, voffA); PG8_STAGE(PG8_SB(1, 1), cB + hstepB + kstep, voffB);
        PG8_WAIT_V(6); PG8_BAR;
    }
    for (;;) {
        const bool has_next = S.next(ui + 1, nxt);
        const char* nA = has_next ? nxt.a : cA; const char* nB = has_next ? nxt.b : cB; const int nt = cur.nt;
        for (int t = 0; t < nt; t += 2) {
            const bool last = (t == nt - 2);
            const char* a1 = cA + (size_t)(t + 1) * kstep;
            const char* a2 = last ? nA : cA + (size_t)(t + 2) * kstep; const char* b2 = last ? nB : cB + (size_t)(t + 2) * kstep;
            const char* a3 = a2 + kstep; const char* b3 = b2 + kstep;
            if (last && has_next) S.a_ready(nxt);
            if constexpr (SP2) {
            PG8_LDB(B0, 0, 0); PG8_LDB(B1, 0, 1); PG8_SCHED; PG8_LDA(At, 0, 0); PG8_STAGE(PG8_SA(1, 1), a1 + hstepA, voffA);
            PG8_WAIT_V(8); PG8_WAIT_L(0); PG8_BAR; PG8_MMA(0, 0, At, B0); PG8_MMA(0, 1, At, B1); PG8_BAR; PG8_SCHED;
            PG8_LDA(At, 0, 1); PG8_STAGE(PG8_SB(0, 0), b2, voffB); PG8_STAGE(PG8_SB(0, 1), b2 + hstepB, voffB); PG8_STAGE(PG8_SA(0, 0), a2, voffA);
            PG8_WAIT_V(8); PG8_WAIT_L(0); PG8_BAR; PG8_MMA(1, 0, At, B0); PG8_MMA(1, 1, At, B1); PG8_BAR; PG8_SCHED;
            PG8_LDB(B0, 1, 0); PG8_LDB(B1, 1, 1); PG8_SCHED; PG8_LDA(At, 1, 0); PG8_STAGE(PG8_SA(0, 1), a2 + hstepA, voffA);
            PG8_WAIT_V(8); PG8_WAIT_L(0); PG8_BAR; PG8_MMA(0, 0, At, B0); PG8_MMA(0, 1, At, B1); PG8_BAR; PG8_SCHED;
            PG8_LDA(At, 1, 1); PG8_STAGE(PG8_SB(1, 0), b3, voffB); PG8_STAGE(PG8_SB(1, 1), b3 + hstepB, voffB); PG8_STAGE(PG8_SA(1, 0), a3, voffA);
            PG8_WAIT_V(8); PG8_WAIT_L(0); PG8_BAR; PG8_MMA(1, 0, At, B0); PG8_MMA(1, 1, At, B1); PG8_BAR; PG8_SCHED;
            } else {
            PG8_LDB(B0, 0, 0); PG8_SCHED; PG8_LDA(At, 0, 0); PG8_STAGE(PG8_SA(1, 1), a1 + hstepA, voffA);
            PG8_WAIT_L(8); PG8_BAR; PG8_WAIT_L(0); PG8_MMA(0, 0, At, B0); PG8_BAR; PG8_SCHED;
            PG8_LDB(B1, 0, 1); PG8_STAGE(PG8_SB(0, 0), b2, voffB);
            PG8_BAR; PG8_WAIT_L(0); PG8_MMA(0, 1, At, B1); PG8_BAR;
            PG8_LDA(At, 0, 1); PG8_STAGE(PG8_SA(0, 0), a2, voffA);
            PG8_BAR; PG8_WAIT_L(0); PG8_MMA(1, 0, At, B0); PG8_BAR; PG8_SCHED;
            PG8_STAGE(PG8_SB(0, 1), b2 + hstepB, voffB);
            PG8_WAIT_V(6); PG8_BAR; PG8_MMA(1, 1, At, B1); PG8_BAR;
            PG8_LDB(B0, 1, 0); PG8_SCHED; PG8_LDA(At, 1, 0); PG8_STAGE(PG8_SA(0, 1), a2 + hstepA, voffA);
            PG8_WAIT_L(8); PG8_BAR; PG8_WAIT_L(0); PG8_MMA(0, 0, At, B0); PG8_BAR; PG8_SCHED;
            PG8_LDB(B1, 1, 1); PG8_STAGE(PG8_SB(1, 0), b3, voffB);
            PG8_BAR; PG8_WAIT_L(0); PG8_MMA(0, 1, At, B1); PG8_BAR;
            PG8_LDA(At, 1, 1); PG8_STAGE(PG8_SA(1, 0), a3, voffA);
            PG8_BAR; PG8_WAIT_L(0); PG8_MMA(1, 0, At, B0); PG8_BAR; PG8_SCHED;
            PG8_STAGE(PG8_SB(1, 1), b3 + hstepB, voffB);
            PG8_WAIT_V(6); PG8_BAR; PG8_MMA(1, 1, At, B1); PG8_BAR;
            }
        }
        if constexpr (ALIGN_EPI) { if (wr == 0) PG8_BAR; }
        if constexpr (!Epi::AFTER_DRAIN) { E(acc, cur, wr, wc, fr, fq); S.done(cur); }
        else { if (has_next) { E(acc, cur, wr, wc, fr, fq); S.done(cur); } }
        if (!has_next) break;
#pragma unroll
        for (int a = 0; a < 2; ++a)
#pragma unroll
            for (int b = 0; b < 2; ++b)
#pragma unroll
                for (int m = 0; m < 4; ++m)
#pragma unroll
                    for (int n = 0; n < 2; ++n) acc[a][b][m][n] = (f32x4){0.f, 0.f, 0.f, 0.f};
        cur = nxt; cA = nA; cB = nB; ++ui;
        if constexpr (ALIGN_EPI) { if (wr == 1) PG8_BAR; }
    }
    PG8_WAIT_V(0);
    if constexpr (!ALIGN_EPI) { if (wr == 0) PG8_BAR; }
    PG8_BAR;
    if constexpr (Epi::AFTER_DRAIN) { E.fused(acc, cur, wr, wc, fr, fq, lds, wid, lane); S.done(cur); }
#undef PG8_SA
#undef PG8_SB
#undef PG8_STAGE
#undef PG8_LDA
#undef PG8_LDB
#undef PG8_MMA
#undef PG8_WAIT_V
#undef PG8_WAIT_L
#undef PG8_BAR
#undef PG8_SCHED
}
}

constexpr int NWAVES = 8;
constexpr int D = 2048, NBATCH = 4, SEQ = 2048, MP = NBATCH * SEQ;
constexpr int DBATCH = 32, DSEQ = 4, MS = DBATCH * DSEQ;
constexpr int MR = MP + MS, MPAD = 8448;
constexpr int FF = 5632, NGU = 2 * FF;
constexpr int NIN = 7760, NINP = 7936;
constexpr int ZU = 0, ZQ = 1024, ZK = 2048, ZV = 2304, ZQI = 2560, ZKI = 3584, ZWI = 3648, ZGA = 3664, ZGB = 5712;
constexpr int PAST = 8192, NPAGES = 64, LTOT = PAST + DSEQ, SSCLD = 8448;
constexpr float EPS = 1e-6f;
constexpr float QSCALE = 0.08838834764831845f * 1.4426950408889634f;
constexpr size_t O_YP = 0, O_YS = 16777216, O_KP = 17039360, O_VP = 19136512, O_IKP = 21233664, O_SRP = 21757952, O_SIP = 21774336,
                 O_KS = 21790720, O_VS = 21823488, O_IKS = 21856256, O_SRS = 21864448, O_SIS = 21995520, O_END = 22126592;
constexpr size_t MiB = 1u << 20;
constexpr size_t WS_CTL = 0, CTL_ZERO_BYTES = 1 * MiB;
constexpr size_t WS_W1GU = 1 * MiB, WS_W1D = WS_W1GU + 44 * MiB, WS_W2GU = WS_W1D + 22 * MiB, WS_W2D = WS_W2GU + 44 * MiB, WS_WIN = WS_W2D + 22 * MiB,
                 WS_WGLU = WS_WIN + 31 * MiB, WS_WA = WS_WGLU + 2 * MiB, WS_WB = WS_WA + 4 * MiB, WS_WOUT = WS_WB + 4 * MiB,
                 WS_XN = WS_WOUT + 8 * MiB, WS_H = WS_XN + 33 * MiB, WS_X1 = WS_H + 91 * MiB, WS_X2 = WS_X1 + 66 * MiB, WS_Z = WS_X2 + 66 * MiB,
                 WS_QB = WS_Z + 128 * MiB, WS_QIB = WS_QB + 17 * MiB, WS_ZA = WS_QIB + 17 * MiB, WS_AOUT = WS_ZA + 17 * MiB, WS_BOUT = WS_AOUT + 17 * MiB,
                 WS_KB = WS_BOUT + 17 * MiB, WS_VT = WS_KB + 5 * MiB, WS_KIB = WS_VT + 4 * MiB, WS_WIF = WS_KIB + 2 * MiB, WS_MASK = WS_WIF + 1 * MiB,
                 WS_SSC = WS_MASK + 2 * MiB, WS_TMPG = WS_SSC + 5 * MiB, WS_MERGED = WS_TMPG + 33 * MiB, WS_SSMP = WS_MERGED + 33 * MiB, WS_PAS = WS_SSMP + 2 * MiB, WS_PBS = WS_PAS + 4 * MiB, WS_SLAB = WS_PBS + 4 * MiB, WS_SLAB2 = WS_SLAB + 23 * MiB, WS_SLAB3 = WS_SLAB2 + 9 * MiB, WS_END = WS_SLAB3 + 23 * MiB;
constexpr size_t SSMP_LAMB = 0, SSMP_BT = 64 * 1024, SSMP_CT = SSMP_BT + 256 * 1024, SSMP_BBF = SSMP_CT + 256 * 1024;
constexpr int CW_BAR = 4096, CW_CNT = 8192, CW_SSQ1 = 32768, CW_SSQ2 = 49152;
constexpr int LDS_MISC = 151552;
constexpr int LDS_BYTES = 151552 + 256;
constexpr int SSM_WPITCH = 272, SSM_WBYTES = 32 * SSM_WPITCH, SSM_UOFF = 8 * SSM_WBYTES, SSM_EOFF = SSM_UOFF + 8 * 1024;

#define GAS __attribute__((address_space(1)))
#define LAS __attribute__((address_space(3)))
typedef unsigned short bf16;
typedef unsigned v4u __attribute__((ext_vector_type(4)));
typedef unsigned v2u __attribute__((ext_vector_type(2)));
typedef float f32x4 __attribute__((ext_vector_type(4)));
typedef float f32x16 __attribute__((ext_vector_type(16)));
typedef short bf16x8 __attribute__((ext_vector_type(8)));
#define LDS_WAIT() asm volatile("s_waitcnt lgkmcnt(0)" ::: "memory")
#define VM_WAIT() asm volatile("s_waitcnt vmcnt(0)" ::: "memory")
#define MFMA32(a, b, c) __builtin_amdgcn_mfma_f32_32x32x16_bf16((a), (b), (c), 0, 0, 0)
__device__ __forceinline__ unsigned f2bf(float f) { unsigned u = __builtin_bit_cast(unsigned, f); return (u + 0x7fffu + ((u >> 16) & 1u)) >> 16; }
typedef float f32x2_t __attribute__((ext_vector_type(2))); typedef __bf16 bf16x2_t __attribute__((ext_vector_type(2)));
__device__ __forceinline__ unsigned pk2(float lo, float hi) { const f32x2_t v = {lo, hi}; const bf16x2_t b = __builtin_convertvector(v, bf16x2_t); return __builtin_bit_cast(unsigned, b); }
__device__ __forceinline__ float bf2f(unsigned short h) { return __uint_as_float(((unsigned)h) << 16); }
__device__ __forceinline__ float blo(unsigned w) { return __uint_as_float(w << 16); }
__device__ __forceinline__ float bhi(unsigned w) { return __uint_as_float(w & 0xffff0000u); }
__device__ __forceinline__ float wave_sum(float v) {
#pragma unroll
    for (int o = 1; o < 64; o <<= 1) v += __shfl_xor(v, o);
    return v;
}
__device__ __forceinline__ float wave_max(float v) {
#pragma unroll
    for (int o = 1; o < 64; o <<= 1) v = fmaxf(v, __shfl_xor(v, o));
    return v;
}
__device__ __forceinline__ float swap32_max(float x) { auto rr = __builtin_amdgcn_permlane32_swap(__float_as_uint(x), __float_as_uint(x), false, false); return fmaxf(__uint_as_float(rr[0]), __uint_as_float(rr[1])); }
__device__ __forceinline__ float swap32_sum(float x) { auto rr = __builtin_amdgcn_permlane32_swap(__float_as_uint(x), __float_as_uint(x), false, false); return __uint_as_float(rr[0]) + __uint_as_float(rr[1]); }
#define DPP_I(v, ctrl) __builtin_amdgcn_update_dpp(0, (v), (ctrl), 0xF, 0xF, true)
#define DPP_F(v, ctrl) __int_as_float(__builtin_amdgcn_update_dpp(0, __float_as_int(v), (ctrl), 0xF, 0xF, true))
__device__ __forceinline__ int half_sum_i(int v) {
    v += DPP_I(v, 0xB1); v += DPP_I(v, 0x4E); v += DPP_I(v, 0x141); v += DPP_I(v, 0x140);
    auto rr = __builtin_amdgcn_permlane16_swap((unsigned)v, (unsigned)v, false, false); return (int)rr[0] + (int)rr[1];
}
__device__ __forceinline__ float half_sum_f(float v) {
    v += DPP_F(v, 0xB1); v += DPP_F(v, 0x4E); v += DPP_F(v, 0x141); v += DPP_F(v, 0x140);
    auto rr = __builtin_amdgcn_permlane16_swap(__float_as_uint(v), __float_as_uint(v), false, false); return __uint_as_float(rr[0]) + __uint_as_float(rr[1]);
}
__device__ __forceinline__ float half_min_f(float v) {
    v = fminf(v, DPP_F(v, 0xB1)); v = fminf(v, DPP_F(v, 0x4E)); v = fminf(v, DPP_F(v, 0x141)); v = fminf(v, DPP_F(v, 0x140));
    auto rr = __builtin_amdgcn_permlane16_swap(__float_as_uint(v), __float_as_uint(v), false, false); return fminf(__uint_as_float(rr[0]), __uint_as_float(rr[1]));
}
__device__ __forceinline__ float half_max_f(float v) {
    v = fmaxf(v, DPP_F(v, 0xB1)); v = fmaxf(v, DPP_F(v, 0x4E)); v = fmaxf(v, DPP_F(v, 0x141)); v = fmaxf(v, DPP_F(v, 0x140));
    auto rr = __builtin_amdgcn_permlane16_swap(__float_as_uint(v), __float_as_uint(v), false, false); return fmaxf(__uint_as_float(rr[0]), __uint_as_float(rr[1]));
}
__device__ __forceinline__ int wsum_i(int v) { v = half_sum_i(v); auto rr = __builtin_amdgcn_permlane32_swap((unsigned)v, (unsigned)v, false, false); return (int)rr[0] + (int)rr[1]; }
__device__ __forceinline__ float wsum_f(float v) { v = half_sum_f(v); auto rr = __builtin_amdgcn_permlane32_swap(__float_as_uint(v), __float_as_uint(v), false, false); return __uint_as_float(rr[0]) + __uint_as_float(rr[1]); }
__device__ __forceinline__ float wmin_f(float v) { v = half_min_f(v); auto rr = __builtin_amdgcn_permlane32_swap(__float_as_uint(v), __float_as_uint(v), false, false); return fminf(__uint_as_float(rr[0]), __uint_as_float(rr[1])); }
__device__ __forceinline__ float wmax_f(float v) { v = half_max_f(v); auto rr = __builtin_amdgcn_permlane32_swap(__float_as_uint(v), __float_as_uint(v), false, false); return fmaxf(__uint_as_float(rr[0]), __uint_as_float(rr[1])); }
__device__ __forceinline__ long long readlane64(long long v, int l) { const int lo = __builtin_amdgcn_readlane((int)v, l), hi = __builtin_amdgcn_readlane((int)(v >> 32), l); return (long long)(((unsigned long long)(unsigned)hi << 32) | (unsigned)lo); }
#define LANE_F(v, l) __int_as_float(__builtin_amdgcn_readlane(__float_as_int(v), (l)))
__device__ __forceinline__ void sincos_acc(float ang, float& s, float& c) {
    double rev = (double)ang * 0.15915494309189535; rev -= __builtin_rint(rev);
    const float r = (float)rev; s = __builtin_amdgcn_sinf(r); c = __builtin_amdgcn_cosf(r);
}
__device__ __forceinline__ float gelu_tanh(float x) { const float a = 0.7978845608028654f * (x + 0.044715f * x * x * x); return x * __builtin_amdgcn_rcpf(1.f + __builtin_amdgcn_exp2f(-2.f * 1.4426950409f * a)); }
__device__ __forceinline__ unsigned sortable(float x) { const unsigned u = __float_as_uint(x); return (u & 0x80000000u) ? ~u : (u | 0x80000000u); }
__device__ const float ROPE_FQ[24] = { 1.f, 0.440366596f, 0.193922743f, 0.0853971019f, 0.0376060307f, 0.016560439f, 0.00729266461f, 0.00321144587f, 0.00141421356f, 0.000622772379f, 0.000274248188f, 0.000120769735f, 5.3182961e-05f, 2.34199997e-05f, 1.03133862e-05f, 4.54167048e-06f, 1.f, 0.193922743f, 0.0376060307f, 0.00729266461f, 0.00141421356f, 0.000274248188f, 5.3182961e-05f, 1.03133862e-05f };

struct Args {
    const float* in[33]; float* out; unsigned char* ws; int ph_lo, ph_hi;
};
struct Frame {
    LAS unsigned char* lds; volatile LAS unsigned* MISC; unsigned* ctl;
    int tid, lane, wave, vcu, G, gw, NGW;
    const float* const* in; float* out; unsigned char* ws;
};
#define WSP(T, off) ((T*)(F.ws + (off)))
#define XB_TMO      128
#define XB_XCNT(j)  (256  + 64 * (j))
#define XB_XSUB(j)  (1280 + 64 * (j))
#define XB_XGEN(j)  (2304 + 64 * (j))
#define XB_TOP      3328
#define XB_TOPGEN   3392
#define XCD_BAR_WORDS 3456
#define XB_SPIN_CAP (1u << 18)

__device__ __forceinline__ unsigned xb_ld(unsigned* p)              { return __hip_atomic_load(p, __ATOMIC_RELAXED, __HIP_MEMORY_SCOPE_AGENT); }
__device__ __forceinline__ unsigned xb_add(unsigned* p, unsigned v) { return __hip_atomic_fetch_add(p, v, __ATOMIC_RELAXED, __HIP_MEMORY_SCOPE_AGENT); }
__device__ __forceinline__ unsigned xb_xcc_id() { return (unsigned)__builtin_amdgcn_s_getreg((3 << 11) | 20) & 0xFu; }
#define XB_SPIN(cond, bar) do { unsigned _sp = 0; while (cond) { __builtin_amdgcn_s_sleep(1); \
    if ((++_sp & 255u) == 0u) { if (xb_ld(&(bar)[XB_TMO])) break; if (_sp > XB_SPIN_CAP) { atomicAdd(&(bar)[XB_TMO], 1u); break; } } } } while (0)

struct XcdBarrier {
    unsigned* bar; unsigned x;
    volatile LAS unsigned* st;
};

__device__ __forceinline__ XcdBarrier xcd_barrier_post(unsigned* bar, volatile LAS unsigned* st) {
    XcdBarrier b; b.bar = bar; b.x = xb_xcc_id(); b.st = st;
    if (threadIdx.x == 0) (void)xb_add(&bar[XB_XCNT(b.x)], 1u);
    return b;
}
__device__ __forceinline__ void xcd_barrier_complete(unsigned* bar, unsigned x, unsigned& nloc, unsigned& nx) {
    const unsigned G = gridDim.x * gridDim.y * gridDim.z;
    unsigned sum, cnt, mine, sp = 0u;
    for (;;) {
        sum = 0u; cnt = 0u; mine = 0u;
#pragma unroll
        for (unsigned j = 0; j < 16; ++j) { const unsigned c = xb_ld(&bar[XB_XCNT(j)]); sum += c; cnt += (c > 0u) ? 1u : 0u; mine = (j == x) ? c : mine; }
        if (sum == G) break;
        __builtin_amdgcn_s_sleep(1);
        if ((++sp & 255u) == 0u) { if (xb_ld(&bar[XB_TMO])) break; if (sp > XB_SPIN_CAP) { atomicAdd(&bar[XB_TMO], 1u); break; } }
    }
    nloc = mine > 0u ? mine : 1u; nx = cnt > 0u ? cnt : 1u;
}

__device__ __forceinline__ void xcd_barrier(const XcdBarrier& b) {
    asm volatile("s_waitcnt vmcnt(0)" ::: "memory");
    __syncthreads();
    if (threadIdx.x == 0) {
        unsigned* bar = b.bar;
        __builtin_amdgcn_s_waitcnt(0);
        unsigned nloc = b.st[0], nx = b.st[1];
        if (nloc == 0u) { xcd_barrier_complete(bar, b.x, nloc, nx); b.st[0] = nloc; b.st[1] = nx; }
        const unsigned old = xb_add(&bar[XB_XSUB(b.x)], 1u);
        const unsigned gen = old / nloc;
        if (old + 1u == (gen + 1u) * nloc) {
            __builtin_amdgcn_fence(__ATOMIC_RELEASE, "agent");
            asm volatile("s_waitcnt vmcnt(0)" ::: "memory");
            const unsigned og = xb_add(&bar[XB_TOP], 1u);
            const unsigned tg = og / nx;
            if (og + 1u == (tg + 1u) * nx) xb_add(&bar[XB_TOPGEN], 1u);
            else XB_SPIN(xb_ld(&bar[XB_TOPGEN]) == tg, bar);
            __builtin_amdgcn_fence(__ATOMIC_ACQUIRE, "agent");
            xb_add(&bar[XB_XGEN(b.x)], 1u);
            asm volatile("s_waitcnt vmcnt(0)" ::: "memory");
        } else {
            XB_SPIN(xb_ld(&bar[XB_XGEN(b.x)]) == gen, bar);
            __builtin_amdgcn_fence(__ATOMIC_ACQUIRE, "agent");
            asm volatile("s_waitcnt vmcnt(0)" ::: "memory");
        }
    }
    __syncthreads();
}

__device__ __forceinline__ void transpose_item(const float* W, int K, int N, bf16* WT, int kb, int nb, int dst_row0, LAS float* scr, int lane, const float* gain = nullptr) {
    const int k0 = 64 * kb, n0 = 64 * nb; const int nn = n0 + lane;
    float tv[64];
#pragma unroll
    for (int i = 0; i < 64; ++i) tv[i] = (nn < N) ? W[(size_t)(k0 + i) * N + nn] : 0.f;
#pragma unroll
    for (int i = 0; i < 64; ++i) scr[i * 65 + lane] = gain ? tv[i] * gain[k0 + i] : tv[i];
    LDS_WAIT(); asm volatile("" ::: "memory");
    const int c = lane & 7;
#pragma unroll
    for (int j = 0; j < 8; ++j) { const int n = (lane >> 3) + 8 * j; const LAS float* s = scr + (8 * c) * 65 + n;
        v4u o; o.x = pk2(s[0 * 65], s[1 * 65]); o.y = pk2(s[2 * 65], s[3 * 65]); o.z = pk2(s[4 * 65], s[5 * 65]); o.w = pk2(s[6 * 65], s[7 * 65]);
        if (n0 + n < N) *(GAS v4u*)(WT + (size_t)(dst_row0 + n) * K + k0 + 8 * c) = o; }
    LDS_WAIT(); asm volatile("" ::: "memory");
}
__device__ __forceinline__ void rms_row_to_bf16(const float* xrow, const float* gain, bf16* orow, float* copy, const float* slab, int nslab, float scale, int lane) {
    const GAS f32x4* xr = (const GAS f32x4*)xrow + lane; const GAS f32x4* gr = (const GAS f32x4*)gain + lane;
    f32x4 v[8];
#pragma unroll
    for (int j = 0; j < 8; ++j) v[j] = xr[64 * j];
    for (int k = 0; k < nslab; ++k) {
        const GAS f32x4* sr = (const GAS f32x4*)(slab + (size_t)k * 128 * D) + lane;
#pragma unroll
        for (int j = 0; j < 8; ++j) v[j] = v[j] + sr[64 * j] * scale; }
    float s = 0.f;
#pragma unroll
    for (int j = 0; j < 8; ++j) s += (v[j].x * v[j].x + v[j].y * v[j].y) + (v[j].z * v[j].z + v[j].w * v[j].w);
    if (copy) {
#pragma unroll
        for (int j = 0; j < 8; ++j) ((GAS f32x4*)copy + lane)[64 * j] = v[j]; }
    const float r = 1.0f / sqrtf(wave_sum(s) * (1.f / D) + EPS);
    GAS v2u* o8 = (GAS v2u*)orow + lane;
#pragma unroll
    for (int j = 0; j < 8; ++j) { const f32x4 g = gr[64 * j]; v2u w; w.x = pk2(v[j].x * r * g.x, v[j].y * r * g.y); w.y = pk2(v[j].z * r * g.z, v[j].w * r * g.w); o8[64 * j] = w; }
}
__device__ __forceinline__ void zero_fill16(Frame& F, void* p, size_t bytes) {
    GAS v4u* q = (GAS v4u*)p; const size_t n = bytes / 16, T = (size_t)F.NGW * 64;
    for (size_t i = (size_t)F.gw * 64 + F.lane; i < n; i += T) q[i] = (v4u){0u, 0u, 0u, 0u};
}
constexpr int I_GU = (D / 64) * (FF / 64), I_DN = (FF / 64) * (D / 64), I_IN = (D / 64) * ((NIN + 63) / 64), I_GLU = 16 * 16, I_AB = 16 * 32, I_OUT = 32 * 32;
constexpr int N9 = 224 * 8, N11 = 192 * 8, N2 = 80 * 8, C9 = 2 * I_GU, C11 = C9 + N9, C2 = C11 + N11;
constexpr int P8N = 1472, CV_CARVE = 4 * I_GU - P8N;
constexpr int P1X = 64;
constexpr int CV_MAIN = 4 * I_GU + I_DN + I_IN, CV_SMALL = CV_MAIN + I_GLU + 2 * I_AB + I_OUT, CV_END = CV_SMALL + I_DN;
__device__ __forceinline__ void conv_item(Frame& F, const Args& A, int r) {
    LAS float* scr = (LAS float*)(F.lds + F.wave * 16896);
    const int lane = F.lane;
    if (r < I_GU) { const int nnb = FF / 64, kb = r / nnb, nb = r % nnb, n0 = nb * 64; transpose_item(A.in[9], D, FF, WSP(bf16, WS_W1GU), kb, nb, (n0 >> 7) * 256 + (n0 & 127), scr, lane); return; } r -= I_GU;
    if (r < I_GU) { const int nnb = FF / 64, kb = r / nnb, nb = r % nnb, n0 = nb * 64; transpose_item(A.in[10], D, FF, WSP(bf16, WS_W1GU), kb, nb, (n0 >> 7) * 256 + 128 + (n0 & 127), scr, lane); return; } r -= I_GU;
    if (r < I_GU) { const int nnb = FF / 64, kb = r / nnb, nb = r % nnb, n0 = nb * 64; transpose_item(A.in[30], D, FF, WSP(bf16, WS_W2GU), kb, nb, (n0 >> 7) * 256 + (n0 & 127), scr, lane, A.in[29]); return; } r -= I_GU;
    if (r < I_GU) { const int nnb = FF / 64, kb = r / nnb, nb = r % nnb, n0 = nb * 64; transpose_item(A.in[31], D, FF, WSP(bf16, WS_W2GU), kb, nb, (n0 >> 7) * 256 + 128 + (n0 & 127), scr, lane, A.in[29]); return; } r -= I_GU;
    if (r < I_DN) { const int nnb = D / 64, kb = r / nnb, nb = r % nnb; transpose_item(A.in[11], FF, D, WSP(bf16, WS_W1D), kb, nb, nb * 64, scr, lane); return; } r -= I_DN;
    if (r < I_IN) { const int nnb = (NIN + 63) / 64, kb = r / nnb, nb = r % nnb; transpose_item(A.in[13], D, NIN, WSP(bf16, WS_WIN), kb, nb, nb * 64, scr, lane, A.in[12]); return; } r -= I_IN;
    if (r < I_GLU) { const int nnb = 16, kb = r / nnb, nb = r % nnb; transpose_item(A.in[24], 1024, 1024, WSP(bf16, WS_WGLU), kb, nb, nb * 64, scr, lane); return; } r -= I_GLU;
    if (r < I_AB) { const int nnb = 32, kb = r / nnb, nb = r % nnb; transpose_item(A.in[26], 1024, D, WSP(bf16, WS_WA), kb, nb, nb * 64, scr, lane); return; } r -= I_AB;
    if (r < I_AB) { const int nnb = 32, kb = r / nnb, nb = r % nnb; transpose_item(A.in[27], 1024, D, WSP(bf16, WS_WB), kb, nb, nb * 64, scr, lane); return; } r -= I_AB;
    if (r < I_OUT) { const int nnb = 32, kb = r / nnb, nb = r % nnb; transpose_item(A.in[28], D, D, WSP(bf16, WS_WOUT), kb, nb, nb * 64, scr, lane); return; } r -= I_OUT;
    { const int nnb = D / 64, kb = r / nnb, nb = r % nnb; transpose_item(A.in[32], FF, D, WSP(bf16, WS_W2D), kb, nb, nb * 64, scr, lane); }
}
__device__ __forceinline__ void p0_prologue(Frame& F, const Args& A) {
    const int lane = F.lane;
    for (int it = F.gw; it < CV_MAIN - P8N - N9 - N11 - N2 - P1X; it += F.NGW) { int r = it; if (r >= C9) r += N9 + N11 + N2; if (r >= CV_CARVE) r += P8N; conv_item(F, A, r); }
    for (int m = F.gw; m < MR; m += F.NGW) {
        const float* xr = (m < MP) ? A.in[0] + (size_t)m * D : A.in[1] + (size_t)(m - MP) * D;
        rms_row_to_bf16(xr, A.in[8], WSP(bf16, WS_XN) + (size_t)m * D, nullptr, nullptr, 0, 0.f, lane);
    }
    zero_fill16(F, WSP(bf16, WS_XN) + (size_t)MR * D, (size_t)(MPAD - MR) * D * 2);
    zero_fill16(F, WSP(bf16, WS_WIN) + (size_t)NIN * D, (size_t)(NINP - NIN) * D * 2);
    zero_fill16(F, WSP(bf16, WS_ZA) + (size_t)MR * 1024, (size_t)(MPAD - MR) * 1024 * 2);
    zero_fill16(F, WSP(bf16, WS_BOUT) + (size_t)MR * 1024, (size_t)(MPAD - MR) * 1024 * 2);
    zero_fill16(F, WSP(bf16, WS_MERGED) + (size_t)MR * D, (size_t)(MPAD - MR) * D * 2);
    {
        float* LAMB = (float*)(F.ws + WS_SSMP + SSMP_LAMB); bf16* BT = (bf16*)(F.ws + WS_SSMP + SSMP_BT); bf16* CT = (bf16*)(F.ws + WS_SSMP + SSMP_CT); float* BBF = (float*)(F.ws + WS_SSMP + SSMP_BBF);
        const int T = F.NGW * 64, gt = F.gw * 64 + lane;
        for (int pr = gt; pr < 64 * 64 * 16; pr += T) {
            const int idx = pr >> 4, c = pr & 15, g = idx >> 6, p = idx & 63;
            const float lre = A.in[16][idx], lim = A.in[17][idx], dt = expf(A.in[23][g]);
            const float e = expf(lre * dt); float sn, cs; sincos_acc(lim * dt, sn, cs);
            const float lbr = e * cs, lbi = e * sn;
            const float nr = lbr - 1.f, ni = lbi, den = 1.f / (lre * lre + lim * lim);
            const float cr = (nr * lre + ni * lim) * den, ci = (ni * lre - nr * lim) * den;
            if (c == 0) { LAMB[2 * idx] = lbr; LAMB[2 * idx + 1] = lbi; }
            const float br = A.in[18][pr], bi = A.in[19][pr];
            const float xr = cr * br - ci * bi, xi = cr * bi + ci * br;
            BT[(g * 128 + p) * 16 + c] = (bf16)f2bf(xr); BT[(g * 128 + 64 + p) * 16 + c] = (bf16)f2bf(xi);
            BBF[pr * 2] = xr; BBF[pr * 2 + 1] = xi;
        }
        for (int idx = gt; idx < 64 * 16 * 128; idx += T) {
            const int gc = idx >> 7, comp = idx & 127;
            const float v = (comp & 1) ? -A.in[21][gc * 64 + (comp >> 1)] : A.in[20][gc * 64 + (comp >> 1)];
            CT[idx] = (bf16)f2bf(v);
        }
    }
}
__device__ __forceinline__ void ld16bf(const bf16* p, float (&x)[16]) {
    const v4u a = *(const GAS v4u*)p, b = *(const GAS v4u*)(p + 8);
    x[0] = blo(a.x); x[1] = bhi(a.x); x[2] = blo(a.y); x[3] = bhi(a.y); x[4] = blo(a.z); x[5] = bhi(a.z); x[6] = blo(a.w); x[7] = bhi(a.w);
    x[8] = blo(b.x); x[9] = bhi(b.x); x[10] = blo(b.y); x[11] = bhi(b.y); x[12] = blo(b.z); x[13] = bhi(b.z); x[14] = blo(b.w); x[15] = bhi(b.w);
}
__device__ __forceinline__ void st16bf(bf16* p, const float (&x)[16]) {
    v4u a, b; a.x = pk2(x[0], x[1]); a.y = pk2(x[2], x[3]); a.z = pk2(x[4], x[5]); a.w = pk2(x[6], x[7]); b.x = pk2(x[8], x[9]); b.y = pk2(x[10], x[11]); b.z = pk2(x[12], x[13]); b.w = pk2(x[14], x[15]);
    *(GAS v4u*)p = a; *(GAS v4u*)(p + 8) = b;
}
__device__ __forceinline__ void st16f(float* p, const float (&x)[16]) {
#pragma unroll
    for (int j = 0; j < 4; ++j) *(GAS f32x4*)(p + 4 * j) = (f32x4){x[4 * j], x[4 * j + 1], x[4 * j + 2], x[4 * j + 3]};
}
__device__ __forceinline__ void norm_rope_128(float (&x)[16], const float* gain, int sub, float cs, float sn) {
    float ss = 0.f;
#pragma unroll
    for (int e = 0; e < 16; ++e) ss += x[e] * x[e];
    ss += DPP_F(ss, 0xB1); ss += DPP_F(ss, 0x4E); ss += DPP_F(ss, 0x141);
    const float r = 1.0f / sqrtf(ss * (1.f / 128.f) + EPS);
#pragma unroll
    for (int j = 0; j < 4; ++j) { const f32x4 g = *(const GAS f32x4*)(gain + 16 * sub + 4 * j); x[4 * j] *= r * g.x; x[4 * j + 1] *= r * g.y; x[4 * j + 2] *= r * g.z; x[4 * j + 3] *= r * g.w; }
#pragma unroll
    for (int e = 0; e < 16; ++e) { const float py = DPP_F(x[e], 0xB1), c = LANE_F(cs, e), s = LANE_F(sn, e);
        const float a = x[e] * c - py * s, b = x[e] * c + py * s; x[e] = (sub == 0) ? a : ((sub == 1) ? b : x[e]); }
}
__device__ __forceinline__ void post_row(Frame& F, const Args& A, int row) {
    const int lane = F.lane;
    const bf16* zr = WSP(bf16, WS_Z) + (size_t)row * NINP;
    const bool isp = row < MP;
    const int pos = isp ? (row & (SEQ - 1)) : (PAST + ((row - MP) & 3));
    float cs, sn; sincos_acc((float)pos * ROPE_FQ[lane < 24 ? lane : 0], sn, cs);
    float x[16];
    ld16bf(zr + ZQ + 16 * lane, x); norm_rope_128(x, A.in[14], lane & 7, cs, sn);
#pragma unroll
    for (int e = 0; e < 16; ++e) x[e] *= QSCALE;
    st16bf(WSP(bf16, WS_QB) + (size_t)row * 1024 + 16 * lane, x);
    { const int kl = lane & 15; ld16bf(zr + ZK + 16 * kl, x); norm_rope_128(x, A.in[15], kl & 7, cs, sn);
      float* ko = isp ? F.out + O_KP + (size_t)row * 256 : F.out + O_KS + (size_t)(row - MP) * 256;
      if (lane < 16) { st16f(ko + 16 * kl, x); if (isp) st16bf(WSP(bf16, WS_KB) + ((size_t)(((row >> 11) * 2 + (kl >> 3)) * SEQ + (row & (SEQ - 1)))) * 128 + 16 * (kl & 7), x); } }
    { const int kl = lane & 15; ld16bf(zr + ZV + 16 * kl, x);
      float* vo = isp ? F.out + O_VP + (size_t)row * 256 : F.out + O_VS + (size_t)(row - MP) * 256;
      if (lane < 16) st16f(vo + 16 * kl, x); }
    { ld16bf(zr + ZQI + 16 * lane, x); const bool rot = (lane & 3) == 0;
#pragma unroll
      for (int e = 0; e < 8; ++e) { const float c = LANE_F(cs, 16 + e), s = LANE_F(sn, 16 + e); const float a = x[e] * c - x[e + 8] * s, b = x[e + 8] * c + x[e] * s; if (rot) { x[e] = a; x[e + 8] = b; } }
      st16bf(WSP(bf16, WS_QIB) + (size_t)row * 1024 + 16 * lane, x); }
    { const int kl = lane & 3; ld16bf(zr + ZKI + 16 * kl, x); const bool rot = kl == 0;
#pragma unroll
      for (int e = 0; e < 8; ++e) { const float c = LANE_F(cs, 16 + e), s = LANE_F(sn, 16 + e); const float a = x[e] * c - x[e + 8] * s, b = x[e + 8] * c + x[e] * s; if (rot) { x[e] = a; x[e + 8] = b; } }
      float* io = isp ? F.out + O_IKP + (size_t)row * 64 : F.out + O_IKS + (size_t)(row - MP) * 64;
      if (lane < 4) { st16f(io + 16 * kl, x);
          if (!isp) st16bf(WSP(bf16, WS_KIB) + (size_t)row * 64 + 16 * kl, x);
          else {
              bf16* fp = WSP(bf16, WS_KIB) + ((size_t)(row >> 5) * 4 + kl) * 512 + (row & 31) * 8;
              v4u a, b2; a.x = pk2(x[0], x[1]); a.y = pk2(x[2], x[3]); a.z = pk2(x[4], x[5]); a.w = pk2(x[6], x[7]); b2.x = pk2(x[8], x[9]); b2.y = pk2(x[10], x[11]); b2.z = pk2(x[12], x[13]); b2.w = pk2(x[14], x[15]);
              *(GAS v4u*)fp = a; *(GAS v4u*)(fp + 256) = b2; } } }
    if (lane < 16) WSP(float, WS_WIF)[(size_t)row * 16 + lane] = bf2f(zr[ZWI + lane]) * (0.25f * 0.125f);
}
__device__ __forceinline__ int swap23(int x) { return (x & ~12) | ((x & 4) << 1) | ((x & 8) >> 1); }
__device__ __forceinline__ void vt_item(Frame& F, int item) {
    const int b = item >> 6, g = (item >> 5) & 1, kb = item & 31, tid = F.tid;
    LAS bf16* tile = (LAS bf16*)F.lds;
    const bf16* Z = WSP(bf16, WS_Z);
#pragma unroll
    for (int i = 0; i < 2; ++i) { const int ch = tid + 512 * i, key = ch >> 4, c8 = ch & 15;
        const v4u v = *(const GAS v4u*)(Z + (size_t)(b * SEQ + kb * 64 + key) * NINP + ZV + g * 128 + c8 * 8);
        *(LAS v4u*)(tile + key * 136 + c8 * 8) = v; }
    __syncthreads();
    { const int d = tid & 127, qu = tid >> 7; unsigned w[8];
#pragma unroll
      for (int pp = 0; pp < 8; ++pp) { const unsigned lo = tile[(16 * qu + swap23(2 * pp)) * 136 + d], hi = tile[(16 * qu + swap23(2 * pp + 1)) * 136 + d]; w[pp] = lo | (hi << 16); }
      bf16* dst = WSP(bf16, WS_VT) + ((size_t)(((b * 2 + g) * 64 + kb * 2 + (qu >> 1)) * 128 + d)) * 32 + 16 * (qu & 1);
      *(GAS v4u*)dst = (v4u){w[0], w[1], w[2], w[3]}; *(GAS v4u*)(dst + 8) = (v4u){w[4], w[5], w[6], w[7]}; }
    __syncthreads();
}
__device__ __forceinline__ void p5_post(Frame& F, const Args& A) {
    for (int m = F.gw; m < MR; m += F.NGW) post_row(F, A, m);
    for (int it = F.vcu; it < 256; it += F.G) vt_item(F, it);
}
__device__ __forceinline__ void ssm_tile_bu(const v4u uraw, const bf16x8 (&bfr)[4], LAS unsigned char* W, LAS bf16* Ut, bool keep_u, int lane) {
    const int r = lane & 31, hh = lane >> 5;
    if (keep_u) *(LAS v4u*)(Ut + r * 16 + 8 * hh) = uraw;
    const bf16x8 af = __builtin_bit_cast(bf16x8, uraw);
    f32x16 acc[4];
#pragma unroll
    for (int ct = 0; ct < 4; ++ct) { acc[ct] = (f32x16){}; acc[ct] = MFMA32(af, bfr[ct], acc[ct]); }
#pragma unroll
    for (int j = 0; j < 16; ++j) { const int tok = (j & 3) + 8 * (j >> 2) + 4 * hh;
        *(LAS unsigned*)(W + tok * SSM_WPITCH + r * 4) = pk2(acc[0][j], acc[2][j]); *(LAS unsigned*)(W + tok * SSM_WPITCH + (32 + r) * 4) = pk2(acc[1][j], acc[3][j]); }
}
__device__ __forceinline__ void ssm_prompt_item(Frame& F, const Args& A, int b, int g) {
    const int lane = F.lane, wave = F.wave;
    const bf16* Z = WSP(bf16, WS_Z);
    const float* LAMB = (const float*)(F.ws + WS_SSMP + SSMP_LAMB); const bf16* BT = (const bf16*)(F.ws + WS_SSMP + SSMP_BT); const bf16* CT = (const bf16*)(F.ws + WS_SSMP + SSMP_CT);
    LAS unsigned char* W = F.lds + wave * SSM_WBYTES; LAS bf16* Ut = (LAS bf16*)(F.lds + SSM_UOFF + wave * 1024); LAS float* E = (LAS float*)(F.lds + SSM_EOFF);
    const int r = lane & 31, hh = lane >> 5, rowb = b * SEQ + wave * 256;
    bf16x8 bfr[4];
#pragma unroll
    for (int ct = 0; ct < 4; ++ct) bfr[ct] = *(const GAS bf16x8*)(BT + (size_t)((g * 128 + ct * 32 + r) * 16 + 8 * hh));
    const float lr = LAMB[(g * 64 + lane) * 2], li = LAMB[(g * 64 + lane) * 2 + 1];
    float hr = 0.f, hi = 0.f;
    const bf16* up = Z + (size_t)(rowb + r) * NINP + ZU + g * 16 + 8 * hh;
    v4u ucur = *(const GAS v4u*)up;
    for (int tt = 0; tt < 8; ++tt) {
        const v4u unow = ucur; ucur = *(const GAS v4u*)(up + (size_t)((tt < 7 ? tt + 1 : 7) * 32) * NINP);
        ssm_tile_bu(unow, bfr, W, Ut, false, lane);
        LDS_WAIT(); asm volatile("" ::: "memory");
#pragma unroll 8
        for (int t = 0; t < 32; ++t) { const unsigned bu = *(LAS unsigned*)(W + t * SSM_WPITCH + lane * 4);
            const float nr = lr * hr - li * hi + blo(bu), ni = lr * hi + li * hr + bhi(bu); hr = nr; hi = ni; }
        asm volatile("" ::: "memory");
    }
    E[(wave * 64 + lane) * 2] = hr; E[(wave * 64 + lane) * 2 + 1] = hi;
    __syncthreads();
    if (wave == 0) {
        float pr = lr, pi = li;
#pragma unroll
        for (int k = 0; k < 8; ++k) { const float a = pr * pr - pi * pi, c = 2.f * pr * pi; pr = a; pi = c; }
        float cr = 0.f, ci = 0.f;
#pragma unroll
        for (int c = 0; c < 8; ++c) { const float er = E[(c * 64 + lane) * 2], ei = E[(c * 64 + lane) * 2 + 1];
            E[(c * 64 + lane) * 2] = cr; E[(c * 64 + lane) * 2 + 1] = ci;
            const float nr = pr * cr - pi * ci + er, ni = pr * ci + pi * cr + ei; cr = nr; ci = ni; }
        F.out[O_SRP + (size_t)(b * 64 + g) * 64 + lane] = cr; F.out[O_SIP + (size_t)(b * 64 + g) * 64 + lane] = ci;
    }
    __syncthreads();
    hr = E[(wave * 64 + lane) * 2]; hi = E[(wave * 64 + lane) * 2 + 1];
    bf16x8 cfr[8];
#pragma unroll
    for (int ks = 0; ks < 8; ++ks) { cfr[ks] = (bf16x8){0, 0, 0, 0, 0, 0, 0, 0}; if (r < 16) cfr[ks] = *(const GAS bf16x8*)(CT + (size_t)((g * 16 + r) * 128 + 16 * ks + 8 * hh)); }
    const float dv = (r < 16) ? A.in[22][g * 16 + r] : 0.f;
    bf16* ZA = WSP(bf16, WS_ZA);
    ucur = *(const GAS v4u*)up;
    for (int tt = 0; tt < 8; ++tt) {
        const v4u unow = ucur; ucur = *(const GAS v4u*)(up + (size_t)((tt < 7 ? tt + 1 : 7) * 32) * NINP);
        ssm_tile_bu(unow, bfr, W, Ut, true, lane);
        LDS_WAIT(); asm volatile("" ::: "memory");
#pragma unroll 8
        for (int t = 0; t < 32; ++t) { const unsigned bu = *(LAS unsigned*)(W + t * SSM_WPITCH + lane * 4);
            const float nr = lr * hr - li * hi + blo(bu), ni = lr * hi + li * hr + bhi(bu); hr = nr; hi = ni;
            *(LAS unsigned*)(W + t * SSM_WPITCH + lane * 4) = pk2(hr, hi); }
        LDS_WAIT(); asm volatile("" ::: "memory");
        f32x16 y = {};
#pragma unroll
        for (int ks = 0; ks < 8; ++ks) { const bf16x8 hf = *(LAS bf16x8*)(W + r * SSM_WPITCH + (16 * ks + 8 * hh) * 2); y = MFMA32(hf, cfr[ks], y); }
        if (r < 16) {
#pragma unroll
            for (int j = 0; j < 16; ++j) { const int tok = (j & 3) + 8 * (j >> 2) + 4 * hh; const float uv = bf2f(Ut[tok * 16 + r]);
                Ut[tok * 16 + r] = (bf16)f2bf(gelu_tanh(y[j] + dv * uv)); }
        }
        LDS_WAIT(); asm volatile("" ::: "memory");
        { const v4u yv = *(LAS v4u*)(Ut + (lane >> 1) * 16 + (lane & 1) * 8);
          *(GAS v4u*)(ZA + (size_t)(rowb + 32 * tt + (lane >> 1)) * 1024 + g * 16 + (lane & 1) * 8) = yv; }
        LDS_WAIT(); asm volatile("" ::: "memory");
    }
    __syncthreads();
}
__device__ __forceinline__ void ssm_sample_item(Frame& F, const Args& A, int item) {
    const int lane = F.lane, db = item >> 6, g = item & 63;
    const float* LAMB = (const float*)(F.ws + WS_SSMP + SSMP_LAMB); const float* BBF = (const float*)(F.ws + WS_SSMP + SSMP_BBF);
    const float lr = LAMB[(g * 64 + lane) * 2], li = LAMB[(g * 64 + lane) * 2 + 1];
    float hr = A.in[5][(size_t)(db * 64 + g) * 64 + lane], hi = A.in[6][(size_t)(db * 64 + g) * 64 + lane];
    f32x4 bb[8];
#pragma unroll
    for (int j = 0; j < 8; ++j) bb[j] = *(const GAS f32x4*)(BBF + (size_t)((g * 64 + lane) * 16) * 2 + 4 * j);
    const bool up0 = (lane ^ (lane >> 2)) & 1, up1 = ((lane >> 1) ^ (lane >> 2)) & 1, up2 = (lane >> 2) & 1, up3 = (lane >> 3) & 1;
    const int chl = (up3 ? 8 : 0) | (up2 ? 4 : 0) | (up1 ? 2 : 0) | (up0 ? 1 : 0);
    const float dv = (lane < 16) ? A.in[22][g * 16 + chl] : 0.f;
    for (int j = 0; j < DSEQ; ++j) {
        const int row = MP + db * DSEQ + j;
        float u[16]; ld16bf(WSP(bf16, WS_Z) + (size_t)row * NINP + ZU + g * 16, u);
        float br = 0.f, bi = 0.f;
#pragma unroll
        for (int c = 0; c < 8; ++c) { br += bb[c].x * u[2 * c] + bb[c].z * u[2 * c + 1]; bi += bb[c].y * u[2 * c] + bb[c].w * u[2 * c + 1]; }
        const float nr = lr * hr - li * hi + br, ni = lr * hi + li * hr + bi; hr = nr; hi = ni;
        float v[16];
#pragma unroll
        for (int ch = 0; ch < 16; ++ch) { const float cre = A.in[20][(size_t)(g * 16 + ch) * 64 + lane], cim = A.in[21][(size_t)(g * 16 + ch) * 64 + lane]; v[ch] = cre * hr - cim * hi; }
#pragma unroll
        for (int e = 0; e < 8; ++e) { const float keep = up0 ? v[2 * e + 1] : v[2 * e], send = up0 ? v[2 * e] : v[2 * e + 1]; v[e] = keep + DPP_F(send, 0xB1); }
#pragma unroll
        for (int e = 0; e < 4; ++e) { const float keep = up1 ? v[2 * e + 1] : v[2 * e], send = up1 ? v[2 * e] : v[2 * e + 1]; v[e] = keep + DPP_F(send, 0x4E); }
#pragma unroll
        for (int e = 0; e < 2; ++e) { const float keep = up2 ? v[2 * e + 1] : v[2 * e], send = up2 ? v[2 * e] : v[2 * e + 1]; v[e] = keep + DPP_F(send, 0x141); }
        { const float keep = up3 ? v[1] : v[0], send = up3 ? v[0] : v[1]; v[0] = keep + DPP_F(send, 0x128); }
        float ymine = v[0];
        { auto r1 = __builtin_amdgcn_permlane16_swap(__float_as_uint(ymine), __float_as_uint(ymine), false, false); ymine = __uint_as_float(r1[0]) + __uint_as_float(r1[1]); }
        ymine = swap32_sum(ymine);
        float umine = 0.f;
#pragma unroll
        for (int ch = 0; ch < 16; ++ch) umine = (chl == ch) ? u[ch] : umine;
        if (lane < 16) WSP(bf16, WS_ZA)[(size_t)row * 1024 + g * 16 + chl] = (bf16)f2bf(gelu_tanh(ymine + dv * umine));
    }
    F.out[O_SRS + (size_t)(db * 64 + g) * 64 + lane] = hr; F.out[O_SIS + (size_t)(db * 64 + g) * 64 + lane] = hi;
}
__device__ __forceinline__ int idx_prompt_score(Frame& F, int b, int t0) {
    const int lane = F.lane, r = lane & 31, hh = lane >> 5;
    const int qa = (r >> 2) & 1, ha = (r & 3) + 4 * (r >> 3);
    const bf16* qrow = WSP(bf16, WS_QIB) + (size_t)(b * SEQ + t0 + qa) * 1024 + ha * 64 + 8 * hh;
    bf16x8 af[4];
#pragma unroll
    for (int ks = 0; ks < 4; ++ks) af[ks] = *(const GAS bf16x8*)(qrow + 16 * ks);
    float w[16];
    { const float* wp = WSP(float, WS_WIF) + (size_t)(b * SEQ + t0 + hh) * 16;
#pragma unroll
      for (int j = 0; j < 4; ++j) { const f32x4 v = *(const GAS f32x4*)(wp + 4 * j); w[4 * j] = v.x; w[4 * j + 1] = v.y; w[4 * j + 2] = v.z; w[4 * j + 3] = v.w; } }
    const int t = t0 + hh, nkt = ((t0 + 1) >> 5) + 1;
    const bf16* kbase = WSP(bf16, WS_KIB) + (size_t)b * SEQ * 64 + (hh * 32 + r) * 8;
    LAS float* ksc = (LAS float*)(F.lds + F.wave * 16384);
    const float qnan = __builtin_nanf("");
    const int nkt4 = (nkt + 3) & ~3;
    bf16x8 ba[4][4], bb[4][4];
#define IX_LOAD(S, KT0) do { _Pragma("unroll") for (int u = 0; u < 4; ++u) _Pragma("unroll") for (int ks = 0; ks < 4; ++ks) S[u][ks] = *(const GAS bf16x8*)(kbase + (size_t)(((KT0) + u) * 4 + ks) * 512); } while (0)
#define IX_COMP(S, KT0) do { _Pragma("unroll") for (int u = 0; u < 4; ++u) { const int kt = (KT0) + u; f32x16 acc = {}; \
            _Pragma("unroll") for (int ks = 0; ks < 4; ++ks) acc = MFMA32(af[ks], S[u][ks], acc); \
            float s = 0.f; \
            _Pragma("unroll") for (int j = 0; j < 16; ++j) s = fmaf(w[j], __builtin_amdgcn_fmed3f(acc[j], 0.f, __builtin_inff()), s); \
            ksc[kt * 64 + lane] = (kt * 32 + r <= t) ? s : qnan; } \
        asm volatile("" ::: "memory"); __builtin_amdgcn_sched_barrier(0); } while (0)
    IX_LOAD(ba, 0);
    for (int kt0 = 0; kt0 < nkt4; kt0 += 8) {
        const bool hasb = kt0 + 4 < nkt4;
        if (hasb) { IX_LOAD(bb, kt0 + 4); asm volatile("s_waitcnt vmcnt(16)" ::: "memory"); } else asm volatile("s_waitcnt vmcnt(0)" ::: "memory");
        __builtin_amdgcn_sched_barrier(0);
        IX_COMP(ba, kt0);
        if (hasb) {
            if (kt0 + 8 < nkt4) { IX_LOAD(ba, kt0 + 8); asm volatile("s_waitcnt vmcnt(16)" ::: "memory"); } else asm volatile("s_waitcnt vmcnt(0)" ::: "memory");
            __builtin_amdgcn_sched_barrier(0);
            IX_COMP(bb, kt0 + 4);
        }
    }
#undef IX_COMP
#undef IX_LOAD
    return nkt4;
}
template <int NK> __device__ __forceinline__ void idx_prompt_select(Frame& F, int b, int t0, int nkt4) {
    const int lane = F.lane, hh = lane >> 5; const int t = t0 + hh;
    LAS float* ksc = (LAS float*)(F.lds + F.wave * 16384);
    const float qnan = __builtin_nanf("");
    for (int kt = nkt4; kt < NK; ++kt) ksc[kt * 64 + lane] = qnan;
    LDS_WAIT(); asm volatile("" ::: "memory");
    float sc[NK];
#pragma unroll
    for (int kt = 0; kt < NK; ++kt) sc[kt] = ksc[kt * 64 + lane];
    LDS_WAIT(); asm volatile("" ::: "memory");
    float thr = -__builtin_inff();
    bool done = (t + 1 <= 256);
    if (!__all(done)) {
        float lo = sc[0], hi = sc[0];
#pragma unroll
        for (int kt = 1; kt < NK; ++kt) { lo = fminf(lo, sc[kt]); hi = fmaxf(hi, sc[kt]); }
        lo = half_min_f(lo); hi = half_max_f(hi);
        if (!done) thr = lo;
        for (int it = 0; it < 48; ++it) {
            const float mid = 0.5f * lo + 0.5f * hi;
            int cnt = 0;
#pragma unroll
            for (int kt = 0; kt < NK; ++kt) cnt += (sc[kt] >= mid) ? 1 : 0;
            cnt = half_sum_i(cnt);
            if (!done) {
                if (!(mid > lo && mid < hi)) done = true;
                else if (cnt == 256) { thr = mid; done = true; }
                else if (cnt > 256) { lo = mid; thr = mid; }
                else hi = mid;
            }
            if (__all(done)) break;
        }
    }
    unsigned w0 = 0u, w1 = 0u;
#pragma unroll
    for (int kt = 0; kt < NK; ++kt) { const unsigned long long bm = __ballot(sc[kt] >= thr); if (lane == kt) { w0 = (unsigned)bm; w1 = (unsigned)(bm >> 32); } }
    unsigned* mk = WSP(unsigned, WS_MASK) + (size_t)(b * SEQ + t0) * 64;
    mk[lane] = w0; mk[64 + lane] = w1;
}
__device__ __forceinline__ void idx_sample_item(Frame& F, const Args& A, int item) {
    const int lane = F.lane, r = lane & 31, hh = lane >> 5, db = item >> 6, pg = item & 63;
    const int qa = (r >> 2) & 1, ha = (r & 3) + 4 * (r >> 3), base = MP + db * DSEQ;
    bf16x8 af[2][4]; float w[2][16];
#pragma unroll
    for (int rt = 0; rt < 2; ++rt) {
        const bf16* qrow = WSP(bf16, WS_QIB) + (size_t)(base + 2 * rt + qa) * 1024 + ha * 64 + 8 * hh;
#pragma unroll
        for (int ks = 0; ks < 4; ++ks) af[rt][ks] = *(const GAS bf16x8*)(qrow + 16 * ks);
        const float* wp = WSP(float, WS_WIF) + (size_t)(base + 2 * rt + hh) * 16;
#pragma unroll
        for (int j = 0; j < 4; ++j) { const f32x4 v = *(const GAS f32x4*)(wp + 4 * j); w[rt][4 * j] = v.x; w[rt][4 * j + 1] = v.y; w[rt][4 * j + 2] = v.z; w[rt][4 * j + 3] = v.w; }
    }
    float* ssc = WSP(float, WS_SSC);
    {
        const int phys = ((const int*)A.in[7])[db * NPAGES + pg];
        f32x4 kx[4][8];
#pragma unroll
        for (int k4 = 0; k4 < 4; ++k4) { const float* kr = A.in[4] + ((size_t)phys * 128 + 32 * k4 + r) * 64 + 8 * hh;
#pragma unroll
            for (int ks = 0; ks < 4; ++ks) { kx[k4][2 * ks] = *(const GAS f32x4*)(kr + 16 * ks); kx[k4][2 * ks + 1] = *(const GAS f32x4*)(kr + 16 * ks + 4); } }
        asm volatile("s_waitcnt vmcnt(0)" ::: "memory"); __builtin_amdgcn_sched_barrier(0);
#pragma unroll
        for (int k4 = 0; k4 < 4; ++k4) {
            f32x16 acc0 = {}, acc1 = {};
#pragma unroll
            for (int ks = 0; ks < 4; ++ks) { const f32x4 a = kx[k4][2 * ks], c = kx[k4][2 * ks + 1];
                v4u pk; pk.x = pk2(a.x, a.y); pk.y = pk2(a.z, a.w); pk.z = pk2(c.x, c.y); pk.w = pk2(c.z, c.w); const bf16x8 bk = __builtin_bit_cast(bf16x8, pk);
                acc0 = MFMA32(af[0][ks], bk, acc0); acc1 = MFMA32(af[1][ks], bk, acc1); }
            float s0 = 0.f, s1 = 0.f;
#pragma unroll
            for (int j = 0; j < 16; ++j) { s0 = fmaf(w[0][j], __builtin_amdgcn_fmed3f(acc0[j], 0.f, __builtin_inff()), s0); s1 = fmaf(w[1][j], __builtin_amdgcn_fmed3f(acc1[j], 0.f, __builtin_inff()), s1); }
            const int kidx = pg * 128 + 32 * k4 + r;
            ssc[(size_t)(db * DSEQ + hh) * SSCLD + kidx] = s0; ssc[(size_t)(db * DSEQ + 2 + hh) * SSCLD + kidx] = s1;
        }
    }
    if (pg == NPAGES - 1) {
        const bf16* kr = WSP(bf16, WS_KIB) + (size_t)(base + (r & 3)) * 64 + 8 * hh;
        f32x16 acc0 = {}, acc1 = {};
#pragma unroll
        for (int ks = 0; ks < 4; ++ks) { const bf16x8 bk = *(const GAS bf16x8*)(kr + 16 * ks); acc0 = MFMA32(af[0][ks], bk, acc0); acc1 = MFMA32(af[1][ks], bk, acc1); }
        float s0 = 0.f, s1 = 0.f;
#pragma unroll
        for (int j = 0; j < 16; ++j) { s0 = fmaf(w[0][j], __builtin_amdgcn_fmed3f(acc0[j], 0.f, __builtin_inff()), s0); s1 = fmaf(w[1][j], __builtin_amdgcn_fmed3f(acc1[j], 0.f, __builtin_inff()), s1); }
        if (r < DSEQ) { const float ninf = -__builtin_inff();
            ssc[(size_t)(db * DSEQ + hh) * SSCLD + PAST + r] = (r <= hh) ? s0 : ninf; ssc[(size_t)(db * DSEQ + 2 + hh) * SSCLD + PAST + r] = (r <= 2 + hh) ? s1 : ninf; }
    }
}
#ifndef P6_REP
#define P6_REP 0
#endif
__device__ __forceinline__ void p6_mix_a(Frame& F, const Args& A) {
    for (int rr = 0; rr <= ((P6_REP >> 0) & 1); ++rr)
    for (int it = F.vcu; it < 256; it += F.G) ssm_prompt_item(F, A, it >> 6, it & 63);
    for (int rr = 0; rr <= ((P6_REP >> 1) & 1); ++rr)
    for (int it = F.gw; it < DBATCH * 64; it += F.NGW) ssm_sample_item(F, A, it);
    for (int rr = 0; rr <= ((P6_REP >> 2) & 1); ++rr)
    for (int it = F.gw; it < 2048; it += F.NGW) {
        const int b = it >> 9, i = it & 511;
        for (int rep = 0; rep < 2; ++rep) { const int t0 = rep ? 2 * (1023 - i) : 2 * i; const int n4 = idx_prompt_score(F, b, t0);
            switch ((n4 + 7) >> 3) { case 1: idx_prompt_select<8>(F, b, t0, n4); break; case 2: idx_prompt_select<16>(F, b, t0, n4); break; case 3: idx_prompt_select<24>(F, b, t0, n4); break; case 4: idx_prompt_select<32>(F, b, t0, n4); break;
                case 5: idx_prompt_select<40>(F, b, t0, n4); break; case 6: idx_prompt_select<48>(F, b, t0, n4); break; case 7: idx_prompt_select<56>(F, b, t0, n4); break; default: idx_prompt_select<64>(F, b, t0, n4); break; } }
    }
    for (int rr = 0; rr <= ((P6_REP >> 3) & 1); ++rr)
    for (int it = F.gw; it < DBATCH * 64; it += F.NGW) idx_sample_item(F, A, it);
}
constexpr int AT_KP = 272, AT_VP = 80, AT_KB = 32 * AT_KP, AT_VB = 128 * AT_VP, AT_BUF = AT_KB + AT_VB, AT_GRP = 2 * AT_BUF, AT_X = 2 * AT_GRP;
__device__ __forceinline__ void attn_tile(LAS unsigned char* kb, const bf16x8 (&kf)[4], const bf16x8 (&qf)[8], f32x16 (&o)[4], float& m, float& l, unsigned mwc, int cq, int hh) {
    const unsigned mw = mwc >> (4 * hh);
    f32x16 s;
#pragma unroll
    for (int j = 0; j < 16; ++j) s[j] = ((mw >> ((j & 3) + 8 * (j >> 2))) & 1u) ? 0.f : -1e30f;
#pragma unroll
    for (int ks = 0; ks < 4; ++ks) s = MFMA32(kf[ks], qf[ks], s);
#pragma unroll
    for (int ks = 4; ks < 8; ++ks) { const bf16x8 kl = *(const LAS bf16x8*)(kb + cq * AT_KP + (16 * ks + 8 * hh) * 2); s = MFMA32(kl, qf[ks], s); }
    bf16x8 vf[4];
#pragma unroll
    for (int dt = 0; dt < 2; ++dt)
#pragma unroll
        for (int s2 = 0; s2 < 2; ++s2) vf[2 * dt + s2] = *(const LAS bf16x8*)(kb + AT_KB + (dt * 32 + cq) * AT_VP + (16 * s2 + 8 * hh) * 2);
    __builtin_amdgcn_sched_barrier(0);
    float mx = -1e30f;
#pragma unroll
    for (int j = 0; j < 16; ++j) mx = fmaxf(mx, s[j]);
    mx = swap32_max(mx);
    const float mn = fmaxf(m, mx), alpha = __builtin_amdgcn_exp2f(m - mn); m = mn;
    float ps = 0.f;
#pragma unroll
    for (int j = 0; j < 16; ++j) { const float p = __builtin_amdgcn_exp2f(s[j] - mn); s[j] = p; ps += p; }
    l = l * alpha + ps;
    if (!__all(alpha == 1.0f)) {
#pragma unroll
        for (int dt = 0; dt < 4; ++dt) o[dt] = o[dt] * alpha; }
    bf16x8 pf[2];
#pragma unroll
    for (int s2 = 0; s2 < 2; ++s2) { v4u pk; pk.x = pk2(s[8 * s2], s[8 * s2 + 1]); pk.y = pk2(s[8 * s2 + 2], s[8 * s2 + 3]); pk.z = pk2(s[8 * s2 + 4], s[8 * s2 + 5]); pk.w = pk2(s[8 * s2 + 6], s[8 * s2 + 7]); pf[s2] = __builtin_bit_cast(bf16x8, pk); }
#pragma unroll
    for (int dt = 0; dt < 4; ++dt)
#pragma unroll
        for (int s2 = 0; s2 < 2; ++s2) { if (dt < 2) o[dt] = MFMA32(vf[2 * dt + s2], pf[s2], o[dt]);
            else { const bf16x8 vl = *(const LAS bf16x8*)(kb + AT_KB + (dt * 32 + cq) * AT_VP + (16 * s2 + 8 * hh) * 2); o[dt] = MFMA32(vl, pf[s2], o[dt]); } }
}
__device__ __forceinline__ void attn_block(Frame& F, int b, int g, int i) {
    const int lane = F.lane, wave = F.wave, cq = lane & 31, hh = lane >> 5, hq = wave & 3, kh = wave >> 2, head = 4 * g + hq;
    const int q256 = hq * 64 + lane;
    const int qrow = b * SEQ + 32 * i + cq;
    bf16x8 qf[8];
    { const bf16* qp = WSP(bf16, WS_QB) + (size_t)qrow * 1024 + head * 128 + 8 * hh;
#pragma unroll
      for (int ks = 0; ks < 8; ++ks) qf[ks] = *(const GAS bf16x8*)(qp + 16 * ks); }
    f32x16 o[4] = {{}, {}, {}, {}}; float m = -1e30f, l = 0.f;
    const bf16* ksrc = WSP(bf16, WS_KB) + (size_t)(b * 2 + g) * SEQ * 128;
    const bf16* vsrc = WSP(bf16, WS_VT) + (size_t)(b * 2 + g) * 64 * 4096;
    const unsigned* mp = WSP(unsigned, WS_MASK) + (size_t)qrow * 64;
    LAS unsigned char* gb = F.lds + kh * AT_GRP;
    const int kw0 = (q256 >> 4) * AT_KP + (q256 & 15) * 16, kw1 = ((q256 + 256) >> 4) * AT_KP + (q256 & 15) * 16;
    const int vw0 = (q256 >> 2) * AT_VP + (q256 & 3) * 16, vw1 = ((q256 + 256) >> 2) * AT_VP + (q256 & 3) * 16;
    const int nsteps = (i + 2) >> 1;
#define AT_LOAD(K0, K1, V0, V1, MW, T) do { K0 = *(const GAS v4u*)(ksrc + (size_t)(T) * 4096 + q256 * 8); K1 = *(const GAS v4u*)(ksrc + (size_t)(T) * 4096 + (q256 + 256) * 8); \
        V0 = *(const GAS v4u*)(vsrc + (size_t)(T) * 4096 + q256 * 8); V1 = *(const GAS v4u*)(vsrc + (size_t)(T) * 4096 + (q256 + 256) * 8); MW = mp[T]; } while (0)
#define AT_STORE(BUF, K0, K1, V0, V1) do { *(LAS v4u*)((BUF) + kw0) = K0; *(LAS v4u*)((BUF) + kw1) = K1; *(LAS v4u*)((BUF) + AT_KB + vw0) = V0; *(LAS v4u*)((BUF) + AT_KB + vw1) = V1; } while (0)
    v4u ak0 = {0u, 0u, 0u, 0u}, ak1 = ak0, av0 = ak0, av1 = ak0, bk0 = ak0, bk1 = ak0, bv0 = ak0, bv1 = ak0; unsigned amw = 0u, bmw = 0u, mwc = 0u, mwp = 0u;
    if (kh <= i) { v4u k0, k1, v0, v1; AT_LOAD(k0, k1, v0, v1, mwp, kh); AT_STORE(gb, k0, k1, v0, v1); }
    if (kh + 2 <= i) AT_LOAD(bk0, bk1, bv0, bv1, bmw, kh + 2);
    if (kh + 4 <= i) AT_LOAD(ak0, ak1, av0, av1, amw, kh + 4);
#define AT_STEP(ST, K0, K1, V0, V1, MW) do { \
        __syncthreads(); \
        const int kt = 2 * (ST) + kh; \
        LAS unsigned char* kb = gb + ((ST) & 1) * AT_BUF; LAS unsigned char* nb = gb + (((ST) + 1) & 1) * AT_BUF; \
        mwc = mwp; \
        bf16x8 kf[4];                                                  \
        _Pragma("unroll") for (int ks = 0; ks < 4; ++ks) kf[ks] = *(const LAS bf16x8*)(kb + cq * AT_KP + (16 * ks + 8 * hh) * 2); \
        __builtin_amdgcn_sched_barrier(0); \
        if (kt + 2 <= i) { AT_STORE(nb, K0, K1, V0, V1); mwp = MW; } \
        if (kt + 6 <= i) AT_LOAD(K0, K1, V0, V1, MW, kt + 6); \
        if (kt <= i) attn_tile(kb, kf, qf, o, m, l, mwc, cq, hh); \
    } while (0)
    for (int st = 0; st < nsteps; st += 2) {
        AT_STEP(st, bk0, bk1, bv0, bv1, bmw);
        if (st + 1 < nsteps) AT_STEP(st + 1, ak0, ak1, av0, av1, amw);
    }
#undef AT_STEP
#undef AT_STORE
#undef AT_LOAD
    if (m < -1e29f) { l = 0.f;
#pragma unroll
        for (int dt = 0; dt < 4; ++dt) o[dt] = o[dt] * 0.f; }
    LAS float* X = (LAS float*)(F.lds + AT_X) + (size_t)(hq * 64 + lane) * 67;
    if (kh == 1) { X[0] = m; X[1] = l;
#pragma unroll
        for (int dt = 0; dt < 4; ++dt)
#pragma unroll
            for (int j = 0; j < 16; ++j) X[2 + dt * 16 + j] = o[dt][j]; }
    __syncthreads();
    if (kh == 0) {
        const float m1 = X[0], l1 = X[1], mt = fmaxf(m, m1), a0 = __builtin_amdgcn_exp2f(m - mt), a1 = __builtin_amdgcn_exp2f(m1 - mt);
        const float lt = swap32_sum(l * a0 + l1 * a1), inv = 1.0f / lt;
        bf16* op = WSP(bf16, WS_BOUT) + (size_t)qrow * 1024 + head * 128;
#pragma unroll
        for (int dt = 0; dt < 4; ++dt)
#pragma unroll
            for (int jq = 0; jq < 4; ++jq) { float v[4];
#pragma unroll
                for (int e = 0; e < 4; ++e) v[e] = (o[dt][4 * jq + e] * a0 + X[2 + dt * 16 + 4 * jq + e] * a1) * inv;
                v2u wv; wv.x = pk2(v[0], v[1]); wv.y = pk2(v[2], v[3]); *(GAS v2u*)(op + 32 * dt + 8 * jq + 4 * hh) = wv; }
    }
    __syncthreads();
}
__device__ __forceinline__ void attn_sample_item(Frame& F, const Args& A, int item) {
    const int tid = F.tid, lane = F.lane, wave = F.wave, qi = item >> 1, grp = item & 1, db = qi >> 2;
    LAS int* red = (LAS int*)F.lds;
    LAS int* cntw = (LAS int*)(F.lds + 128);
    LAS int* sel = (LAS int*)(F.lds + 256);
    LAS float* lg = (LAS float*)(F.lds + 2048);
    LAS float* linv = (LAS float*)(F.lds + 2048 + 4096);
    LAS float* Op = (LAS float*)(F.lds + 8192);
    const float* sc = WSP(float, WS_SSC) + (size_t)qi * SSCLD;
    LAS float* redf = (LAS float*)(F.lds + 1536);
    float key[17]; const float qnan = __builtin_nanf("");
#pragma unroll
    for (int e = 0; e < 17; ++e) { const int idx = tid + 512 * e; key[e] = qnan; if (idx < LTOT) { const float x = sc[idx]; key[e] = (x == -__builtin_inff()) ? qnan : x; } }
    if (tid == 0) cntw[0] = 0;
    float lo = key[0], hi = key[0];
#pragma unroll
    for (int e = 1; e < 17; ++e) { lo = fminf(lo, key[e]); hi = fmaxf(hi, key[e]); }
    lo = wmin_f(lo); hi = wmax_f(hi);
    if (lane == 0) { redf[2 * wave] = lo; redf[2 * wave + 1] = hi; }
    __syncthreads();
#pragma unroll
    for (int w = 0; w < 8; ++w) { lo = fminf(lo, redf[2 * w]); hi = fmaxf(hi, redf[2 * w + 1]); }
    float thr = lo;
    for (int it = 0; it < 32; ++it) {
        const float q2 = 0.5f * lo + 0.5f * hi, q1 = 0.5f * lo + 0.5f * q2, q3 = 0.5f * q2 + 0.5f * hi;
        if (!(q2 > lo && q2 < hi)) break;
        int c12 = 0, c3 = 0;
#pragma unroll
        for (int e = 0; e < 17; ++e) { c12 += ((key[e] >= q1) ? 1 : 0) + ((key[e] >= q2) ? 65536 : 0); c3 += (key[e] >= q3) ? 1 : 0; }
        c12 = wsum_i(c12); c3 = wsum_i(c3);
        LAS int* rb = red + (it & 1) * 16;
        if (lane == 0) { rb[wave] = c12; rb[8 + wave] = c3; }
        __syncthreads();
        int t12 = 0, t3 = 0;
#pragma unroll
        for (int w = 0; w < 8; ++w) { t12 += rb[w]; t3 += rb[8 + w]; }
        const int t1 = t12 & 65535, t2 = t12 >> 16;
        if (t3 >= 256) { lo = q3; thr = q3; if (t3 == 256) break; }
        else if (t2 >= 256) { lo = q2; hi = q3; thr = q2; if (t2 == 256) break; }
        else if (t1 >= 256) { lo = q1; hi = q2; thr = q1; if (t1 == 256) break; }
        else hi = q1;
    }
    __syncthreads();
#pragma unroll
    for (int e = 0; e < 17; ++e) if (key[e] >= thr) { const int pos = atomicAdd((int*)cntw, 1); if (pos < 256) sel[pos] = tid + 512 * e; }
    __syncthreads();
    const int nsel = cntw[0] < 256 ? cntw[0] : 256;
    const int* pt = (const int*)A.in[7] + db * NPAGES;
    const int half = lane >> 5, l32 = lane & 31;
    long long roff = 0;
    { const int si = 32 * wave + l32; const int sk = (si < nsel) ? sel[si] : 0;
      roff = (sk < PAST) ? ((long long)pt[sk >> 7] * 128 + (sk & 127)) * 256 : -(long long)(1 + sk - PAST); }
    float qv[4][4];
    { const bf16* qp = WSP(bf16, WS_QB) + (size_t)(MP + qi) * 1024 + (4 * grp) * 128 + 4 * l32;
#pragma unroll
      for (int hq = 0; hq < 4; ++hq) { const v2u q2 = *(const GAS v2u*)(qp + hq * 128); qv[hq][0] = blo(q2.x); qv[hq][1] = bhi(q2.x); qv[hq][2] = blo(q2.y); qv[hq][3] = bhi(q2.y); } }
    f32x4 vv[16];
    {
        f32x4 kv[16];
#pragma unroll
        for (int kk = 0; kk < 16; ++kk) { const long long ro = half ? readlane64(roff, 2 * kk + 1) : readlane64(roff, 2 * kk);
            const float* kr = (ro >= 0) ? A.in[2] + ro : F.out + O_KS + (size_t)(db * DSEQ + (-ro - 1)) * 256;
            const float* vr = (ro >= 0) ? A.in[3] + ro : F.out + O_VS + (size_t)(db * DSEQ + (-ro - 1)) * 256;
            kv[kk] = *(const GAS f32x4*)(kr + grp * 128 + 4 * l32); vv[kk] = *(const GAS f32x4*)(vr + grp * 128 + 4 * l32); }
#pragma unroll
        for (int kk = 0; kk < 16; ++kk) { const int si = 32 * wave + 2 * kk + half;
#pragma unroll
            for (int hq = 0; hq < 4; ++hq) { float p = qv[hq][0] * kv[kk].x + qv[hq][1] * kv[kk].y + qv[hq][2] * kv[kk].z + qv[hq][3] * kv[kk].w;
                p = half_sum_f(p);
                if (l32 == 0) lg[hq * 256 + si] = (si < nsel) ? p : -1e30f; } }
    }
    __syncthreads();
    if (wave < 4) {
        float x[4]; float mx = -1e30f;
#pragma unroll
        for (int e = 0; e < 4; ++e) { x[e] = lg[wave * 256 + lane + 64 * e]; mx = fmaxf(mx, x[e]); }
        mx = wmax_f(mx); float sum = 0.f;
#pragma unroll
        for (int e = 0; e < 4; ++e) { const float p = (lane + 64 * e < nsel) ? __builtin_amdgcn_exp2f(x[e] - mx) : 0.f; lg[wave * 256 + lane + 64 * e] = p; sum += p; }
        sum = wsum_f(sum); if (lane == 0) linv[wave] = 1.0f / sum;
    }
    __syncthreads();
    {
        float acc[4][4];
#pragma unroll
        for (int hq = 0; hq < 4; ++hq)
#pragma unroll
            for (int e = 0; e < 4; ++e) acc[hq][e] = 0.f;
#pragma unroll
        for (int kk = 0; kk < 16; ++kk) { const int si = 32 * wave + 2 * kk + half;
#pragma unroll
            for (int hq = 0; hq < 4; ++hq) { const float p = lg[hq * 256 + si]; acc[hq][0] += p * vv[kk].x; acc[hq][1] += p * vv[kk].y; acc[hq][2] += p * vv[kk].z; acc[hq][3] += p * vv[kk].w; } }
#pragma unroll
        for (int hq = 0; hq < 4; ++hq) {
#pragma unroll
            for (int e = 0; e < 4; ++e) acc[hq][e] = swap32_sum(acc[hq][e]);
            if (half == 0) *(LAS f32x4*)(Op + wave * 512 + hq * 128 + 4 * l32) = (f32x4){acc[hq][0], acc[hq][1], acc[hq][2], acc[hq][3]}; }
    }
    __syncthreads();
    { float sres = 0.f;
#pragma unroll
      for (int w = 0; w < 8; ++w) sres += Op[w * 512 + tid];
      WSP(bf16, WS_BOUT)[(size_t)(MP + qi) * 1024 + grp * 512 + tid] = (bf16)f2bf(sres * linv[tid >> 7]); }
    __syncthreads();
}
#ifndef P7_REP_S
#define P7_REP_S 0
#endif
#ifndef P7_REP_A
#define P7_REP_A 0
#endif
__device__ __forceinline__ void p7_mix_b(Frame& F, const Args& A) {
    for (int rr = 0; rr <= P7_REP_S; ++rr)
    for (int it = F.vcu; it < 2 * MS; it += F.G) attn_sample_item(F, A, it);
    for (int rr = 0; rr <= P7_REP_A; ++rr)
    for (int it = F.vcu; it < 256; it += F.G) { const int b = it >> 6, g = (it >> 5) & 1, p = it & 31; for (int rep = 0; rep < 2; ++rep) attn_block(F, b, g, rep ? 63 - p : p); }
}
constexpr int LDS_RS = 131072;
__device__ __forceinline__ const LAS _Float16* make_rowscale(Frame& F, const float* ssq) {
    LAS _Float16* t = (LAS _Float16*)(F.lds + LDS_RS);
    typedef _Float16 h4_t __attribute__((ext_vector_type(4)));
    for (int i = F.tid; i < MPAD / 4; i += NWAVES * 64) { const f32x4 q = ((const GAS f32x4*)ssq)[i];
        h4_t o; o.x = (_Float16)(1.0f / sqrtf(q.x * (1.0f / D) + EPS)); o.y = (_Float16)(1.0f / sqrtf(q.y * (1.0f / D) + EPS)); o.z = (_Float16)(1.0f / sqrtf(q.z * (1.0f / D) + EPS)); o.w = (_Float16)(1.0f / sqrtf(q.w * (1.0f / D) + EPS));
        *(LAS h4_t*)(t + 4 * i) = o; }
    __syncthreads();
    return t;
}
#ifndef MK_N_LAUNCHES
#define MK_N_LAUNCHES 1
#endif
constexpr int NPH = 16;
constexpr int N_LAUNCHES = MK_N_LAUNCHES;
__global__ void __launch_bounds__(NWAVES * 64, 2) mk_fwd(Args args) {
    extern __shared__ __attribute__((aligned(16))) unsigned char lds_raw[];
    Frame F;
    F.lds = (LAS unsigned char*)lds_raw;
    F.MISC = (volatile LAS unsigned*)(F.lds + LDS_MISC);
    F.tid = threadIdx.x; F.lane = F.tid & 63; F.wave = __builtin_amdgcn_readfirstlane(F.tid >> 6);
    F.G = gridDim.x; { const int bx = blockIdx.x; F.vcu = (F.G % 8 == 0) ? (bx % 8) * (F.G / 8) + bx / 8 : bx; }
    F.gw = F.vcu * NWAVES + F.wave; F.NGW = F.G * NWAVES;
    F.out = args.out; F.ws = args.ws; F.ctl = (unsigned*)(args.ws + WS_CTL);
    for (int u = F.tid; u < 64; u += NWAVES * 64) ((LAS unsigned*)(F.lds + LDS_MISC))[u] = 0u;
    __syncthreads();
    XcdBarrier bar; bar.bar = F.ctl + CW_BAR; bar.x = 0; bar.st = nullptr;
    if (N_LAUNCHES == 1) bar = xcd_barrier_post(F.ctl + CW_BAR, F.MISC + 8);
#define GRID_BAR() do { if (N_LAUNCHES == 1) xcd_barrier(bar); } while (0)
    const int lo = args.ph_lo, hi = args.ph_hi;
#ifndef PHASE_MASK
#define PHASE_MASK 0xffff
#endif
#ifndef REPEAT_MASK
#define REPEAT_MASK 0
#endif
#define RPT(k) (((REPEAT_MASK) >> (k)) & 1)
#define IN(k) ((((PHASE_MASK) >> (k)) & 1) && lo <= (k) && (k) < hi)
    const Args& A = args;
    if (IN(0)) _Pragma("unroll") for (int rep_ = 0; rep_ <= RPT(0); ++rep_) { p0_prologue(F, A); GRID_BAR(); }
    if (IN(1)) _Pragma("unroll") for (int rep_ = 0; rep_ <= RPT(1); ++rep_) { pg8::Gemm g{D, D}; pg8::MixOrder S; S.init(33, NGU / 256, F.G, (int)blockIdx.x, 1, D / 64, 0, 0, WSP(bf16, WS_XN), WSP(bf16, WS_W1GU), nullptr, nullptr, D, D);
        pg8::EpiSwiglu E{WSP(bf16, WS_H), FF, nullptr};
        pg8::gemm_phase<pg8::EpiSwiglu, pg8::MixOrder, true, true>(F.lds, g, S, E);
        { const int full = S.so.nwg - (S.so.nwg / F.G) * F.G;
          if ((int)blockIdx.x >= full && rep_ == 0) for (int it = CV_MAIN - P1X + ((int)blockIdx.x - full) * NWAVES + F.wave; it < CV_SMALL; it += (F.G - full) * NWAVES) conv_item(F, A, it); }
        GRID_BAR(); }
    if (IN(2)) _Pragma("unroll") for (int rep_ = 0; rep_ <= RPT(2); ++rep_) { pg8::Gemm g{FF, FF}; pg8::MixOrder S; S.init(32, D / 256, F.G, (int)blockIdx.x, 1, FF / 64, 22, 4, WSP(bf16, WS_H), WSP(bf16, WS_W1D), nullptr, nullptr, FF, FF);
        pg8::EpiResNorm E{A.in[0], WSP(float, WS_X1), WSP(bf16, WS_XN), (float*)(F.ctl + CW_SSQ1), D, 0.5f, WSP(float, WS_SLAB), A.in[1], WSP(float, WS_X1) + (size_t)MP * D, F.ctl + CW_CNT, F.ctl + CW_BAR + XB_TMO, 22};
        pg8::gemm_phase<pg8::EpiResNorm, pg8::MixOrder, true, true>(F.lds, g, S, E);
        if ((int)blockIdx.x >= 176 && rep_ == 0) conv_item(F, A, C2 + ((int)blockIdx.x - 176) * NWAVES + F.wave);
        GRID_BAR(); }
    if (IN(4)) _Pragma("unroll") for (int rep_ = 0; rep_ <= RPT(4); ++rep_) { pg8::Gemm g{D, D}; pg8::MixOrder S; S.init(33, NINP / 256, F.G, (int)blockIdx.x, 1, D / 64, 0, 0, WSP(bf16, WS_XN), WSP(bf16, WS_WIN), nullptr, nullptr, D, D);
        pg8::EpiBf16Plain E{WSP(bf16, WS_Z), NINP, make_rowscale(F, (const float*)(F.ctl + CW_SSQ1))};
        pg8::gemm_phase<pg8::EpiBf16Plain, pg8::MixOrder, true, true>(F.lds, g, S, E); GRID_BAR(); }
    if (IN(5)) _Pragma("unroll") for (int rep_ = 0; rep_ <= RPT(5); ++rep_) { p5_post(F, A); GRID_BAR(); }
    if (IN(6)) _Pragma("unroll") for (int rep_ = 0; rep_ <= RPT(6); ++rep_) { p6_mix_a(F, A); GRID_BAR(); }
    if (IN(7)) _Pragma("unroll") for (int rep_ = 0; rep_ <= RPT(7); ++rep_) { p7_mix_b(F, A); GRID_BAR(); }
    if (IN(8)) _Pragma("unroll") for (int rep_ = 0; rep_ <= RPT(8); ++rep_) { pg8::Gemm g{1024, 1024}; pg8::GluBOrder S; S.init(F.G, (int)blockIdx.x, WSP(bf16, WS_ZA), WSP(bf16, WS_WGLU), WSP(bf16, WS_BOUT), WSP(bf16, WS_WB));
        pg8::EpiGluB E{WSP(bf16, WS_AOUT), WSP(bf16, WS_ZA), A.in[25], WSP(bf16, WS_TMPG), WSP(bf16, WS_Z) + ZGB, NINP, WSP(float, WS_PBS)};
        pg8::gemm_phase<pg8::EpiGluB, pg8::GluBOrder, true, true>(F.lds, g, S, E);
        if ((int)blockIdx.x >= 164 && rep_ == 0) for (int it = CV_CARVE + ((int)blockIdx.x - 164) * NWAVES + F.wave; it < 4 * I_GU; it += (F.G - 164) * NWAVES) conv_item(F, A, it);
        GRID_BAR(); }
    if (IN(9)) _Pragma("unroll") for (int rep_ = 0; rep_ <= RPT(9); ++rep_) { pg8::Gemm g{1024, 1024}; pg8::MixOrder S; S.init(32, D / 256, F.G, (int)blockIdx.x, 1, 16, 4, 4, WSP(bf16, WS_AOUT), WSP(bf16, WS_WA), nullptr, nullptr, 1024, 1024);
        pg8::EpiBranchA E{WSP(bf16, WS_TMPG), WSP(bf16, WS_MERGED), D, WSP(bf16, WS_Z) + ZGA, NINP, WSP(float, WS_PAS)};
        pg8::gemm_phase<pg8::EpiBranchA, pg8::MixOrder, true, true>(F.lds, g, S, E);
        if ((int)blockIdx.x >= 32 && rep_ == 0) conv_item(F, A, C9 + ((int)blockIdx.x - 32) * NWAVES + F.wave);
        GRID_BAR(); }
    if (IN(11)) _Pragma("unroll") for (int rep_ = 0; rep_ <= RPT(11); ++rep_) {
        if ((int)blockIdx.x < 64) { const int kq = (int)blockIdx.x >> 3; const float* PAs = WSP(float, WS_PAS); const float* PBs = WSP(float, WS_PBS); const bf16* Z = WSP(bf16, WS_Z);
            for (int ch = F.tid; ch < 128 * 32; ch += NWAVES * 64) { const int r = ch >> 5, c = kq * 256 + (ch & 31) * 8;
                const v4u gaw = *(const GAS v4u*)(Z + (size_t)(MP + r) * NINP + ZGA + c), gbw = *(const GAS v4u*)(Z + (size_t)(MP + r) * NINP + ZGB + c);
                f32x4 pa0 = {0.f, 0.f, 0.f, 0.f}, pa1 = pa0, pb0 = pa0, pb1 = pa0;
#pragma unroll
                for (int k = 0; k < 4; ++k) { const size_t o = ((size_t)k * 128 + r) * D + c;
                    pa0 = pa0 + *(const GAS f32x4*)(PAs + o); pa1 = pa1 + *(const GAS f32x4*)(PAs + o + 4); pb0 = pb0 + *(const GAS f32x4*)(PBs + o); pb1 = pb1 + *(const GAS f32x4*)(PBs + o + 4); }
                const float ga[8] = {blo(gaw.x), bhi(gaw.x), blo(gaw.y), bhi(gaw.y), blo(gaw.z), bhi(gaw.z), blo(gaw.w), bhi(gaw.w)}, gb[8] = {blo(gbw.x), bhi(gbw.x), blo(gbw.y), bhi(gbw.y), blo(gbw.z), bhi(gbw.z), blo(gbw.w), bhi(gbw.w)};
                const float pa[8] = {pa0.x, pa0.y, pa0.z, pa0.w, pa1.x, pa1.y, pa1.z, pa1.w}, pb[8] = {pb0.x, pb0.y, pb0.z, pb0.w, pb1.x, pb1.y, pb1.z, pb1.w};
                float o[8];
#pragma unroll
                for (int e = 0; e < 8; ++e) o[e] = pg8::sigm(ga[e]) * pa[e] + pg8::sigm(gb[e]) * pb[e];
                v4u w; w.x = pk2(o[0], o[1]); w.y = pk2(o[2], o[3]); w.z = pk2(o[4], o[5]); w.w = pk2(o[6], o[7]);
                *(GAS v4u*)(WSP(bf16, WS_MERGED) + (size_t)(MP + r) * D + c) = w; }
            VM_WAIT(); __syncthreads(); }
        pg8::Gemm g{D, D}; pg8::MixOrder S; S.init(32, D / 256, F.G, (int)blockIdx.x, 1, D / 64, 8, 4, WSP(bf16, WS_MERGED), WSP(bf16, WS_WOUT), nullptr, nullptr, D, D);
        pg8::EpiResNorm E{WSP(float, WS_X1), WSP(float, WS_X2), WSP(bf16, WS_XN), (float*)(F.ctl + CW_SSQ2), D, 1.0f, WSP(float, WS_SLAB2), WSP(float, WS_X1) + (size_t)MP * D, WSP(float, WS_X2) + (size_t)MP * D, F.ctl + CW_CNT + 512, F.ctl + CW_BAR + XB_TMO, 8};
        pg8::gemm_phase<pg8::EpiResNorm, pg8::MixOrder, true, true>(F.lds, g, S, E);
        if ((int)blockIdx.x >= 64 && rep_ == 0) conv_item(F, A, C11 + ((int)blockIdx.x - 64) * NWAVES + F.wave);
        GRID_BAR(); }
    if (IN(13)) _Pragma("unroll") for (int rep_ = 0; rep_ <= RPT(13); ++rep_) { pg8::Gemm g{D, D}; pg8::MixOrder S; S.init(33, NGU / 256, F.G, (int)blockIdx.x, 1, D / 64, 0, 0, WSP(bf16, WS_XN), WSP(bf16, WS_W2GU), nullptr, nullptr, D, D);
        pg8::EpiSwiglu E{WSP(bf16, WS_H), FF, make_rowscale(F, (const float*)(F.ctl + CW_SSQ2))};
        pg8::gemm_phase<pg8::EpiSwiglu, pg8::MixOrder, true, true>(F.lds, g, S, E);
        { const int full = S.so.nwg - (S.so.nwg / F.G) * F.G;
          if ((int)blockIdx.x >= full && rep_ == 0) for (int it = CV_SMALL + ((int)blockIdx.x - full) * NWAVES + F.wave; it < CV_END; it += (F.G - full) * NWAVES) conv_item(F, A, it); }
        GRID_BAR(); }
    if (IN(14)) _Pragma("unroll") for (int rep_ = 0; rep_ <= RPT(14); ++rep_) { pg8::Gemm g{FF, FF}; pg8::MixOrder S; S.init(32, D / 256, F.G, (int)blockIdx.x, 1, FF / 64, 22, 4, WSP(bf16, WS_H), WSP(bf16, WS_W2D), nullptr, nullptr, FF, FF);
        pg8::EpiResNorm E{WSP(float, WS_X2), F.out, nullptr, nullptr, D, 0.5f, WSP(float, WS_SLAB3), WSP(float, WS_X2) + (size_t)MP * D, F.out + O_YS, F.ctl + CW_CNT + 1024, F.ctl + CW_BAR + XB_TMO, 22};
        pg8::gemm_phase<pg8::EpiResNorm, pg8::MixOrder, true, true>(F.lds, g, S, E); }
#undef IN
}

extern "C" void kernel_launch(void* const* d_in, const int* in_sizes, int n_in, void* d_out, int out_size, void* d_ws, size_t ws_size, hipStream_t stream) {
    static int grid = 0;
    if (grid == 0) {
        if (n_in != 33 || out_size != (int)O_END || ws_size < WS_END) { fprintf(stderr, "kernel_launch: unexpected sizes (n_in %d, out %d, ws %zu); nothing launched\n", n_in, out_size, ws_size); grid = -1; return; }
        int dev = 0, cus = 0, per_cu = 0;
        if (hipGetDevice(&dev) != hipSuccess || hipDeviceGetAttribute(&cus, hipDeviceAttributeMultiprocessorCount, dev) != hipSuccess) { grid = -1; return; }
        if (hipFuncSetAttribute((const void*)mk_fwd, hipFuncAttributeMaxDynamicSharedMemorySize, LDS_BYTES) != hipSuccess) { fprintf(stderr, "kernel_launch: hipFuncSetAttribute failed\n"); grid = -1; return; }
        if (hipOccupancyMaxActiveBlocksPerMultiprocessor(&per_cu, (const void*)mk_fwd, NWAVES * 64, LDS_BYTES) != hipSuccess || per_cu < 1)
            fprintf(stderr, "kernel_launch: note: occupancy query reports %d workgroups per CU\n", per_cu);
        (void)hipGetLastError();
        grid = cus;
        if (cus != 256) { fprintf(stderr, "kernel_launch: built for a 256-CU device (every workgroup owns at most one split-K unit of the sample tile); this device has %d CUs; nothing launched\n", cus); grid = -1; return; }
    }
    if (grid < 0) return;
    if (hipMemsetAsync((char*)d_ws + WS_CTL, 0, CTL_ZERO_BYTES, stream) != hipSuccess) return;
    Args a{};
    for (int i = 0; i < 33; ++i) a.in[i] = (const float*)d_in[i];
    a.out = (float*)d_out; a.ws = (unsigned char*)d_ws;
    for (int li = 0; li < N_LAUNCHES; ++li) {
        a.ph_lo = (N_LAUNCHES == 1) ? 0 : li; a.ph_hi = (N_LAUNCHES == 1) ? NPH : li + 1;
        hipLaunchKernelGGL(mk_fwd, dim3(grid), dim3(NWAVES * 64), LDS_BYTES, stream, a);
        const hipError_t le = hipPeekAtLastError();
        if (le != hipSuccess) { fprintf(stderr, "kernel_launch: launch %d failed: %s\n", li, hipGetErrorName(le)); break; }
    }
}
```
